# Optimizing an MI355X kernel written in HIP

```python
import jax, jax.numpy as jnp
from jax import lax
import numpy as np

D_MODEL = 2048
BATCH = 2
SEQ = 8192
DEPTH = 2

N_MIXERS = 2
N_A_LAYERS = (DEPTH + 1) // 2
N_B_LAYERS = DEPTH // 2
ROPE_THETA = 10000.0
EPS = 1e-6

MLA_HEADS = 16
MLA_Q_RANK = 512
MLA_KV_RANK = 512
MLA_NOPE = 128
MLA_ROPE = 64
MLA_QK = MLA_NOPE + MLA_ROPE
MLA_V = 128
MLA_IN = MLA_Q_RANK + MLA_KV_RANK + MLA_ROPE
Q_BLOCK = 128

DIL_GROUPS = ((128, 1), (512, 4), (2048, 16))
N_DIL_GROUPS = len(DIL_GROUPS)
DIL_HEADS = 16
DIL_HEAD_DIM = 128
DIL_GROUP_W = DIL_HEADS * DIL_HEAD_DIM
DIL_IN = N_DIL_GROUPS * 3 * DIL_GROUP_W

PEER_HEADS = 8
PEER_NKEYS = 128
PEER_EXPERTS = PEER_NKEYS * PEER_NKEYS
PEER_QDIM = 256
PEER_HALF = PEER_QDIM // 2
PEER_TOPK = 16
PEER_CHUNK = 128

kernel_name = 'hybrid_mla_dilated_peer'


def rms_norm(x, gain):
    xf = x.astype(jnp.float32)
    y = xf * lax.rsqrt(jnp.mean(xf * xf, axis=-1, keepdims=True) + EPS)
    return (y * gain.astype(jnp.float32)).astype(x.dtype)


def rope(x, positions):
    half = x.shape[-1] // 2
    inv_freq = ROPE_THETA ** (-jnp.arange(half, dtype=jnp.float32) / half)
    ang = positions.astype(jnp.float32)[..., None] * inv_freq
    ang = ang.reshape(ang.shape[:2] + (1,) * (x.ndim - 3) + (half,))
    cos, sin = jnp.cos(ang), jnp.sin(ang)
    xf = x.astype(jnp.float32)
    x1, x2 = xf[..., :half], xf[..., half:]
    return jnp.concatenate([x1 * cos - x2 * sin, x2 * cos + x1 * sin], axis=-1).astype(x.dtype)


def causal_block_attention(q, k, v, scale):
    B, S, H, Dq = q.shape
    nb = S // Q_BLOCK
    qb = q.reshape(B, nb, Q_BLOCK, H, Dq).transpose(1, 0, 2, 3, 4)
    k_pos = jnp.arange(S)

    def one_block(args):
        qi, bi = args
        s = jnp.einsum('bqhd,bkhd->bhqk', qi, k, preferred_element_type=jnp.float32) * scale
        q_pos = bi * Q_BLOCK + jnp.arange(Q_BLOCK)
        s = jnp.where(k_pos[None, :] <= q_pos[:, None], s, -jnp.inf)
        p = jax.nn.softmax(s, axis=-1)
        return jnp.einsum('bhqk,bkhd->bqhd', p.astype(v.dtype), v)

    o = lax.map(one_block, (qb, jnp.arange(nb)))
    return o.transpose(1, 0, 2, 3, 4).reshape(B, S, H, v.shape[-1])


def mla_mixer(h, positions, w_in, g_q, w_uq, g_kv, w_ukv, g_qn, g_kn, w_o):
    B, S, _ = h.shape
    z = h @ w_in
    c_q, c_kv, k_r = jnp.split(z, [MLA_Q_RANK, MLA_Q_RANK + MLA_KV_RANK], axis=-1)
    q = (rms_norm(c_q, g_q) @ w_uq).reshape(B, S, MLA_HEADS, MLA_QK)
    kv = (rms_norm(c_kv, g_kv) @ w_ukv).reshape(B, S, MLA_HEADS, MLA_NOPE + MLA_V)
    k_nope, v = kv[..., :MLA_NOPE], kv[..., MLA_NOPE:]
    k_rope = jnp.broadcast_to(k_r[:, :, None, :], (B, S, MLA_HEADS, MLA_ROPE))
    k = jnp.concatenate([k_nope, k_rope], axis=-1)
    q = rms_norm(q, g_qn)
    k = rms_norm(k, g_kn)
    q = jnp.concatenate([q[..., :MLA_NOPE], rope(q[..., MLA_NOPE:], positions)], axis=-1)
    k = jnp.concatenate([k[..., :MLA_NOPE], rope(k[..., MLA_NOPE:], positions)], axis=-1)
    o = causal_block_attention(q, k, v, MLA_QK ** -0.5)
    return o.reshape(B, S, MLA_HEADS * MLA_V) @ w_o


def dilated_group_attention(q, k, v, window, dilation):
    B, S, H, dh = q.shape
    steps = window // dilation
    L = S // dilation
    nb = -(-L // steps)
    Lp = nb * steps

    def to_sub(t):
        t = t.reshape(B, L, dilation, H, dh).transpose(0, 2, 3, 1, 4)
        t = jnp.pad(t, ((0, 0), (0, 0), (0, 0), (0, Lp - L), (0, 0)))
        return t.reshape(B, dilation, H, nb, steps, dh)

    def with_prev(t):
        prev = jnp.pad(t, ((0, 0), (0, 0), (0, 0), (1, 0), (0, 0), (0, 0)))[:, :, :, :-1]
        return jnp.concatenate([prev, t], axis=4)

    qs, ks, vs = to_sub(q), to_sub(k), to_sub(v)
    kb, vb = with_prev(ks), with_prev(vs)
    s = jnp.einsum('brhnqd,brhnkd->brhnqk', qs, kb, preferred_element_type=jnp.float32) * dh ** -0.5
    qi = jnp.arange(steps)[:, None]
    kj = jnp.arange(2 * steps)[None, :]
    dist = qi + steps - kj
    blk = jnp.arange(nb)[:, None, None]
    valid = (dist >= 0) & (dist <= steps) & (blk * steps + kj - steps >= 0)
    s = jnp.where(valid, s, -jnp.inf)
    lse = jax.nn.logsumexp(s, axis=-1)
    p = jnp.exp(s - lse[..., None])
    o = jnp.einsum('brhnqk,brhnkd->brhnqd', p.astype(v.dtype), vb)
    o = o.reshape(B, dilation, H, Lp, dh)[:, :, :, :L].transpose(0, 3, 1, 2, 4).reshape(B, S, H, dh)
    lse = lse.reshape(B, dilation, H, Lp)[:, :, :, :L].transpose(0, 3, 1, 2).reshape(B, S, H)
    return o, lse


def dilated_mixer(h, positions, w_in, g_qn, g_kn, w_o):
    B, S, _ = h.shape
    z = (h @ w_in).reshape(B, S, N_DIL_GROUPS, 3, DIL_HEADS, DIL_HEAD_DIM)
    q_all = rope(rms_norm(z[:, :, :, 0], g_qn[:, None, :]), positions)
    k_all = rope(rms_norm(z[:, :, :, 1], g_kn[:, None, :]), positions)
    v_all = z[:, :, :, 2]
    outs, lses = [], []
    for gi, (window, dilation) in enumerate(DIL_GROUPS):
        o, lse = dilated_group_attention(q_all[:, :, gi], k_all[:, :, gi], v_all[:, :, gi], window, dilation)
        outs.append(o)
        lses.append(lse)
    w = jax.nn.softmax(jnp.stack(lses, axis=0), axis=0)
    o = jnp.einsum('gbsh,gbshd->bshd', w.astype(v_all.dtype), jnp.stack(outs, axis=0))
    return o.reshape(B, S, DIL_GROUP_W) @ w_o


def peer_ffn(h, w_q, sub_keys, u_tab, v_tab):
    B, S, D = h.shape
    T = B * S
    x = h.reshape(T, D)
    q = (x @ w_q).reshape(T, PEER_HEADS, 2, PEER_HALF)
    s = jnp.einsum('thpc,hpnc->thpn', q, sub_keys, preferred_element_type=jnp.float32)
    top_s, top_i = lax.top_k(s, PEER_TOPK)
    cand = top_s[:, :, 0, :, None] + top_s[:, :, 1, None, :]
    best_s, best_c = lax.top_k(cand.reshape(T, PEER_HEADS, PEER_TOPK * PEER_TOPK), PEER_TOPK)
    i1 = jnp.take_along_axis(top_i[:, :, 0], best_c // PEER_TOPK, axis=-1)
    i2 = jnp.take_along_axis(top_i[:, :, 1], best_c % PEER_TOPK, axis=-1)
    idx = (i1 * PEER_NKEYS + i2).reshape(T, PEER_HEADS * PEER_TOPK)
    gate = jax.nn.softmax(best_s, axis=-1).reshape(T, PEER_HEADS * PEER_TOPK)
    nc = T // PEER_CHUNK

    def chunk(args):
        xc, ic, gc = args
        u = jnp.take(u_tab, ic, axis=0)
        a = jnp.einsum('cd,ced->ce', xc, u, preferred_element_type=jnp.float32)
        act = (jax.nn.gelu(a, approximate=False) * gc).astype(xc.dtype)
        return jnp.einsum('ce,ced->cd', act, jnp.take(v_tab, ic, axis=0))

    y = lax.map(chunk, (x.reshape(nc, PEER_CHUNK, D), idx.reshape(nc, PEER_CHUNK, -1), gate.reshape(nc, PEER_CHUNK, -1)))
    return y.reshape(B, S, D)


def setup_inputs(seed: int = 0) -> dict:
    key = jax.random.key(seed)
    ks = jax.random.split(key, 24)
    f32 = jnp.float32
    D = D_MODEL

    def nrm(k, shape, scale):
        return jax.random.normal(k, shape, f32) * scale

    def gain(k, shape):
        return 1.0 + 0.05 * jax.random.normal(k, shape, f32)

    return {
        'x': nrm(ks[0], (BATCH, SEQ, D), 1.0),
        'c': nrm(ks[1], (BATCH, D), 1.0),
        'positions': jnp.arange(SEQ, dtype=jnp.int32)[None, :] + jax.random.randint(ks[2], (BATCH, 1), 0, 4096, dtype=jnp.int32),
        'ada_w': nrm(ks[3], (DEPTH, D, 6 * D), 0.5 * D ** -0.5),
        'ada_b': nrm(ks[4], (DEPTH, 6 * D), 0.01),
        'norm_g': gain(ks[5], (DEPTH, 2, D)),
        'mla_w_in': nrm(ks[6], (N_A_LAYERS, D, MLA_IN), D ** -0.5),
        'mla_g_q': gain(ks[7], (N_A_LAYERS, MLA_Q_RANK)),
        'mla_w_uq': nrm(ks[8], (N_A_LAYERS, MLA_Q_RANK, MLA_HEADS * MLA_QK), MLA_Q_RANK ** -0.5),
        'mla_g_kv': gain(ks[9], (N_A_LAYERS, MLA_KV_RANK)),
        'mla_w_ukv': nrm(ks[10], (N_A_LAYERS, MLA_KV_RANK, MLA_HEADS * (MLA_NOPE + MLA_V)), MLA_KV_RANK ** -0.5),
        'mla_g_qn': gain(ks[11], (N_A_LAYERS, MLA_QK)),
        'mla_g_kn': gain(ks[12], (N_A_LAYERS, MLA_QK)),
        'mla_w_o': nrm(ks[13], (N_A_LAYERS, MLA_HEADS * MLA_V, D), (MLA_HEADS * MLA_V) ** -0.5),
        'dil_w_in': nrm(ks[14], (N_B_LAYERS, D, DIL_IN), D ** -0.5),
        'dil_g_qn': gain(ks[15], (N_B_LAYERS, N_DIL_GROUPS, DIL_HEAD_DIM)),
        'dil_g_kn': gain(ks[16], (N_B_LAYERS, N_DIL_GROUPS, DIL_HEAD_DIM)),
        'dil_w_o': nrm(ks[17], (N_B_LAYERS, DIL_GROUP_W, D), DIL_GROUP_W ** -0.5),
        'peer_w_q': nrm(ks[18], (DEPTH, D, PEER_HEADS * PEER_QDIM), D ** -0.5),
        'peer_sub_keys': nrm(ks[19], (DEPTH, PEER_HEADS, 2, PEER_NKEYS, PEER_HALF), PEER_HALF ** -0.5),
        'peer_u': nrm(ks[20], (DEPTH, PEER_EXPERTS, D), D ** -0.5),
        'peer_v': nrm(ks[21], (DEPTH, PEER_EXPERTS, D), PEER_HEADS ** -0.5),
    }


def reference(x, c, positions, ada_w, ada_b, norm_g, mla_w_in, mla_g_q, mla_w_uq, mla_g_kv, mla_w_ukv, mla_g_qn, mla_g_kn, mla_w_o, dil_w_in, dil_g_qn, dil_g_kn, dil_w_o, peer_w_q, peer_sub_keys, peer_u, peer_v):
    mod = jnp.einsum('bd,lde->lbe', jax.nn.silu(c), ada_w) + ada_b[:, None, :]
    for layer in range(DEPTH):
        shift1, scale1, gate1, shift2, scale2, gate2 = jnp.split(mod[layer][:, None, :], 6, axis=-1)
        h = rms_norm(x, norm_g[layer, 0]) * (1.0 + scale1) + shift1
        if layer % N_MIXERS == 0:
            a = layer // N_MIXERS
            y = mla_mixer(h, positions, mla_w_in[a], mla_g_q[a], mla_w_uq[a], mla_g_kv[a], mla_w_ukv[a], mla_g_qn[a], mla_g_kn[a], mla_w_o[a])
        else:
            b = layer // N_MIXERS
            y = dilated_mixer(h, positions, dil_w_in[b], dil_g_qn[b], dil_g_kn[b], dil_w_o[b])
        x = x + gate1 * y
        h = rms_norm(x, norm_g[layer, 1]) * (1.0 + scale2) + shift2
        x = x + gate2 * peer_ffn(h, peer_w_q[layer], peer_sub_keys[layer], peer_u[layer], peer_v[layer])
    return x
```

```cpp
#include <hip/hip_runtime.h>
#include <stdint.h>
#include <stdio.h>

#ifndef MK_ONE_LAUNCH
#define MK_ONE_LAUNCH 1
#endif
#ifndef REP_MASK
#define REP_MASK 0
#endif

#define LAS __attribute__((address_space(3)))
typedef unsigned short bf16_t;
typedef short bf16x8 __attribute__((ext_vector_type(8)));
typedef short s16x4 __attribute__((ext_vector_type(4)));
typedef float f32x4 __attribute__((ext_vector_type(4)));
typedef float f32x2 __attribute__((ext_vector_type(2)));
typedef float f32x16 __attribute__((ext_vector_type(16)));
typedef unsigned u32x4 __attribute__((ext_vector_type(4)));
typedef unsigned u32x2 __attribute__((ext_vector_type(2)));
typedef int i32x4 __attribute__((ext_vector_type(4)));
using bf16x2_t = __attribute__((ext_vector_type(2))) __bf16;

constexpr int DM = 2048, NB = 2, SEQ = 8192, T = NB * SEQ, DEPTH = 2;
constexpr int MLA_H = 16, MLA_QR = 512, MLA_KVR = 512, MLA_NOPE = 128, MLA_ROPE = 64, MLA_QK = 192, MLA_V = 128, MLA_IN = 1088, MLA_IN_PAD = 1280;
constexpr int DIL_G = 3, DIL_H = 16, DIL_DH = 128, DIL_GW = 2048, DIL_IN = 18432;
constexpr int PEER_H = 8, PEER_NK = 128, PEER_E = 16384, PEER_TOPK = 16;
constexpr float EPS = 1e-6f;
constexpr float LOG2E = 1.4426950408889634f;
constexpr float ACT_F8SCALE = 64.f;
constexpr float DIL_WSCALE = 64.f;

constexpr size_t MiB = 1u << 20;
constexpr size_t al256(size_t x) { return (x + 255) & ~(size_t)255; }
constexpr size_t WS_CTL = 0, CTL_BYTES = 1 * MiB;
constexpr size_t CTL_MOD_OFF = 64 * 1024;
constexpr size_t WS_WIN_MLA = WS_CTL + CTL_BYTES;
constexpr size_t WS_WUQ = WS_WIN_MLA + al256((size_t)MLA_IN_PAD * DM * 2);
constexpr size_t WS_WUKV = WS_WUQ + al256((size_t)3072 * 512 * 2);
constexpr size_t WS_WO_MLA = WS_WUKV + al256((size_t)4096 * 512 * 2);
constexpr size_t WS_WIN_DIL = WS_WO_MLA + al256((size_t)DM * DM * 2);
constexpr size_t WS_WO_DIL = WS_WIN_DIL + al256((size_t)DIL_IN * DM * 2);
constexpr size_t WS_WQ = WS_WO_DIL + al256((size_t)DM * DM * 2);
constexpr size_t WS_SUBK = WS_WQ + al256((size_t)2 * DM * DM * 2);
constexpr size_t WS_UTAB = WS_SUBK + al256((size_t)2 * 8 * 2 * 128 * 128 * 2);
constexpr size_t WS_VTAB = WS_UTAB + al256((size_t)PEER_E * DM);
constexpr size_t WS_USC = WS_VTAB + al256((size_t)PEER_E * DM);
constexpr size_t WS_VSC = WS_USC + al256((size_t)PEER_E * 4);
constexpr size_t WS_HB = WS_VSC + al256((size_t)PEER_E * 4);
constexpr size_t WS_XA = WS_HB + al256((size_t)T * DM * 2);
constexpr size_t WS_PQ = WS_XA + (size_t)T * DM * 4;
constexpr size_t WS_XB = WS_PQ + al256((size_t)T * DM * 2);
constexpr size_t WS_IDX = WS_XB + al256((size_t)T * DM * 4);
constexpr size_t WS_GATE = WS_IDX + al256((size_t)T * 128 * 4);
constexpr size_t WS_R1 = WS_GATE + al256((size_t)T * 128 * 4);
constexpr size_t WS_QRAW = WS_XA, WS_KVRAW = WS_XB, WS_OG = WS_XA, WS_LSE = WS_IDX;
constexpr size_t R1_Z = 0;
constexpr size_t R1_CQN = R1_Z + al256((size_t)T * MLA_IN_PAD * 2);
constexpr size_t R1_CKVN = R1_CQN + al256((size_t)T * 512 * 2);
constexpr size_t R1_Q = R1_CKVN + al256((size_t)T * 512 * 2);
constexpr size_t R1_K = R1_Q + al256((size_t)T * 3072 * 2);
constexpr size_t R1_V = R1_K + al256((size_t)T * 3072 * 2);
constexpr size_t R1_END0 = R1_V + al256((size_t)T * DM * 2);
constexpr size_t R1_ZD = 0;
constexpr size_t R1_END1 = R1_ZD + al256((size_t)SEQ * DIL_IN * 2);
constexpr size_t R1_BYTES = R1_END0 > R1_END1 ? R1_END0 : R1_END1;
constexpr size_t WS_ROPE = WS_R1 + R1_BYTES;
constexpr size_t WS_END = WS_ROPE + al256((size_t)2 * T * 64 * 4);
static_assert(WS_END <= (size_t)1116430848, "workspace must fit the guaranteed minimum");

__device__ __forceinline__ float bf2f(unsigned v) { return __uint_as_float(v << 16); }
__device__ __forceinline__ unsigned cvt_pk_bf16(float lo, float hi) { unsigned r; asm volatile("s_nop 0\n\tv_cvt_pk_bf16_f32 %0, %1, %2" : "=v"(r) : "v"(lo), "v"(hi)); return r; }
__device__ __forceinline__ unsigned bf16_rne_bits(float f) { unsigned u = __float_as_uint(f); u += 0x7FFFu + ((u >> 16) & 1u); return u >> 16; }
__device__ __forceinline__ float bflo(unsigned w) { return __uint_as_float(w << 16); }
__device__ __forceinline__ float bfhi(unsigned w) { return __uint_as_float(w & 0xffff0000u); }
__device__ __forceinline__ float dot2(unsigned a, unsigned b, float acc) { return __builtin_amdgcn_fdot2_f32_bf16(__builtin_bit_cast(bf16x2_t, a), __builtin_bit_cast(bf16x2_t, b), acc, false); }
__device__ __forceinline__ float wave_sum(float v) {
#pragma unroll
    for (int o = 32; o >= 1; o >>= 1) v += __shfl_xor(v, o);
    return v;
}
__device__ __forceinline__ int otid() { int t = (int)threadIdx.x; asm volatile("" : "+v"(t)); return t; }
typedef __attribute__((address_space(1))) unsigned char* gptr_t;
__device__ __forceinline__ unsigned char* ow(unsigned char* p) { gptr_t g = (gptr_t)p; asm volatile("" : "+s"(g)); return (unsigned char*)g; }
__device__ __forceinline__ int obid() { int b = (int)blockIdx.x; asm volatile("" : "+s"(b)); return b; }
__device__ __forceinline__ u32x4 pack8f(f32x4 a, f32x4 b) { u32x4 w = {cvt_pk_bf16(a[0], a[1]), cvt_pk_bf16(a[2], a[3]), cvt_pk_bf16(b[0], b[1]), cvt_pk_bf16(b[2], b[3])}; return w; }
__device__ __forceinline__ void unpack8(u32x4 w, float (&f)[8]) { f[0] = bflo(w.x); f[1] = bfhi(w.x); f[2] = bflo(w.y); f[3] = bfhi(w.y); f[4] = bflo(w.z); f[5] = bfhi(w.z); f[6] = bflo(w.w); f[7] = bfhi(w.w); }
__device__ __forceinline__ void sincos_rev(float ang, float& s, float& c) {
    const double x = (double)ang * 0.15915494309189533577;
    const float fr = (float)(x - __builtin_rint(x));
    s = __builtin_amdgcn_sinf(fr); c = __builtin_amdgcn_cosf(fr);
}

#define XB_TMO      128
#define XB_XCNT(j)  (256  + 64 * (j))
#define XB_XSUB(j)  (1280 + 64 * (j))
#define XB_XGEN(j)  (2304 + 64 * (j))
#define XB_TOP      3328
#define XB_TOPGEN   3392
#define XCD_BAR_WORDS 3456
#define XB_SPIN_CAP (1u << 22)
__device__ __forceinline__ unsigned xb_ld(unsigned* p)              { return __hip_atomic_load(p, __ATOMIC_RELAXED, __HIP_MEMORY_SCOPE_AGENT); }
__device__ __forceinline__ unsigned xb_add(unsigned* p, unsigned v) { return __hip_atomic_fetch_add(p, v, __ATOMIC_RELAXED, __HIP_MEMORY_SCOPE_AGENT); }
__device__ __forceinline__ unsigned xb_xcc_id() { return (unsigned)__builtin_amdgcn_s_getreg((3 << 11) | 20) & 0xFu; }
#define XB_SPIN(cond, bar) do { unsigned _sp = 0; while (cond) { __builtin_amdgcn_s_sleep(1); \
    if ((++_sp & 255u) == 0u) { if (xb_ld(&(bar)[XB_TMO])) break; if (_sp > XB_SPIN_CAP) { atomicAdd(&(bar)[XB_TMO], 1u); break; } } } } while (0)
struct XcdBarrier { unsigned* bar; unsigned x; volatile LAS unsigned* st; };
__device__ __forceinline__ XcdBarrier xcd_barrier_post(unsigned* bar, volatile LAS unsigned* st) {
    XcdBarrier b; b.bar = bar; b.x = xb_xcc_id(); b.st = st;
    if (threadIdx.x == 0) (void)xb_add(&bar[XB_XCNT(b.x)], 1u);
    return b;
}
__device__ __forceinline__ void xcd_barrier_complete(unsigned* bar, unsigned x, unsigned& nloc, unsigned& nx) {
    const unsigned G = gridDim.x * gridDim.y * gridDim.z;
    unsigned sum, cnt, mine, sp = 0u;
    for (;;) {
        sum = 0u; cnt = 0u; mine = 0u;
#pragma unroll
        for (unsigned j = 0; j < 16; ++j) { const unsigned c = xb_ld(&bar[XB_XCNT(j)]); sum += c; cnt += (c > 0u) ? 1u : 0u; mine = (j == x) ? c : mine; }
        if (sum == G) break;
        __builtin_amdgcn_s_sleep(1);
        if ((++sp & 255u) == 0u) { if (xb_ld(&bar[XB_TMO])) break; if (sp > XB_SPIN_CAP) { atomicAdd(&bar[XB_TMO], 1u); break; } }
    }
    nloc = mine > 0u ? mine : 1u; nx = cnt > 0u ? cnt : 1u;
}
__device__ __forceinline__ void xcd_barrier(const XcdBarrier& b) {
    asm volatile("s_waitcnt vmcnt(0)" ::: "memory");
    __syncthreads();
    if (threadIdx.x == 0) {
        unsigned* bar = b.bar;
        __builtin_amdgcn_s_waitcnt(0);
        unsigned nloc = b.st[0], nx = b.st[1];
        if (nloc == 0u) { xcd_barrier_complete(bar, b.x, nloc, nx); b.st[0] = nloc; b.st[1] = nx; }
        const unsigned old = xb_add(&bar[XB_XSUB(b.x)], 1u);
        const unsigned gen = old / nloc;
        if (old + 1u == (gen + 1u) * nloc) {
            __builtin_amdgcn_fence(__ATOMIC_RELEASE, "agent");
            asm volatile("s_waitcnt vmcnt(0)" ::: "memory");
            const unsigned og = xb_add(&bar[XB_TOP], 1u);
            const unsigned tg = og / nx;
            if (og + 1u == (tg + 1u) * nx) xb_add(&bar[XB_TOPGEN], 1u);
            else XB_SPIN(xb_ld(&bar[XB_TOPGEN]) == tg, bar);
            __builtin_amdgcn_fence(__ATOMIC_ACQUIRE, "agent");
            xb_add(&bar[XB_XGEN(b.x)], 1u);
            asm volatile("s_waitcnt vmcnt(0)" ::: "memory");
        } else {
            XB_SPIN(xb_ld(&bar[XB_XGEN(b.x)]) == gen, bar);
            __builtin_amdgcn_fence(__ATOMIC_ACQUIRE, "agent");
            asm volatile("s_waitcnt vmcnt(0)" ::: "memory");
        }
    }
    __syncthreads();
}

namespace pg8 {
constexpr int BM = 256, BK = 64, HALF = 128, HTB = HALF * BK * 2, STAGE_BYTES = 8 * HTB, NXCD = 8, WGM = 8;
__host__ __device__ __forceinline__ int lds_byte(int r, int c) { const int st = (r >> 4) * 2 + (c >> 5), rr = r & 15, cc = c & 31, ob = rr * 64 + cc * 2; return st * 1024 + (ob ^ (((ob >> 9) & 1) << 5)); }
__host__ __device__ __forceinline__ void stage_rc(int b, int& R, int& C) { const int st = b / 1024, sb = b % 1024, swz = sb ^ (((sb >> 9) & 1) << 5); R = (st >> 1) * 16 + swz / 64; C = (st & 1) * 32 + (swz % 64) / 2; }
__host__ __device__ __forceinline__ int perm32(int rho) { const int n = rho >> 4, i = rho & 15; return 8 * (i >> 2) + 4 * n + (i & 3); }
struct Unit { int pm, pn; };
struct Gemm { const bf16_t* A; const bf16_t* Bt; int M, N, K; };
struct StaticOrder {
    int nM, nN, nwg, G, c;
    __host__ __device__ void init(int M, int N, int G_, int c_) { nM = M / BM; nN = N / BM; nwg = nM * nN; G = G_; c = c_; }
    __host__ __device__ bool next(int i, Unit& u) const {
        const long L = (long)i * G + c; if (L >= nwg) return false;
        int wgid = (int)L; { const int q = nwg / NXCD, r = nwg % NXCD, xcd = wgid % NXCD, off = wgid / NXCD; wgid = (xcd < r ? xcd * (q + 1) : r * (q + 1) + (xcd - r) * q) + off; }
        const int nig = WGM * nN, gid = wgid / nig, fm = gid * WGM, gsz = (nM - fm) < WGM ? (nM - fm) : WGM;
        u.pm = fm + ((wgid % nig) % gsz); u.pn = (wgid % nig) / gsz; return true;
    }
    __device__ __forceinline__ void a_ready(const Unit&) const {}
    __device__ __forceinline__ void done(const Unit&) const {}
};
struct EpiBf16 {
    static constexpr bool PERM = true;
    bf16_t* O; int ldc; int mode; const unsigned* cs; const float* sn; const float* g_qn; const float* g_kn; LAS float* xch; float oscale; bf16_t* O2;
    __device__ __forceinline__ void operator()(const f32x4 (&acc)[2][2][4][2], const Unit& u, int wr, int wc, int fr, int fq) const {
        { const int l_ = otid() & 63; fr = l_ & 15; fq = l_ >> 4; }
        const int row0 = u.pm * BM + wr * 64 + fr; const int col0 = u.pn * BM + wc * 32 + 8 * fq;
        if (mode == 2) {
#pragma unroll
            for (int ai = 0; ai < 2; ++ai)
#pragma unroll
                for (int m = 0; m < 4; ++m) { const int r = row0 + ai * HALF + m * 16;
#pragma unroll
                    for (int bj = 0; bj < 2; ++bj) { const f32x4 v0 = acc[ai][bj][m][0] * oscale, v1 = acc[ai][bj][m][1] * oscale;
                        u32x4 w; w.x = cvt_pk_bf16(v0[0], v0[1]); w.y = cvt_pk_bf16(v0[2], v0[3]); w.z = cvt_pk_bf16(v1[0], v1[1]); w.w = cvt_pk_bf16(v1[2], v1[3]);
                        const int d0 = wc * 32 + 8 * fq;
                        *(u32x4*)(O + ((size_t)(((r >> 5) * 8 + u.pn) * 2 + bj) << 12) + (size_t)(((d0 >> 4) * 64 + ((d0 >> 3) & 1) * 32 + (r & 31)) * 8)) = w; } }
            return;
        }
        if (mode == 0) {
#pragma unroll
            for (int ai = 0; ai < 2; ++ai)
#pragma unroll
                for (int m = 0; m < 4; ++m) { bf16_t* rowp = O + (size_t)(row0 + ai * HALF + m * 16) * ldc + col0;
#pragma unroll
                    for (int bj = 0; bj < 2; ++bj) { const f32x4 v0 = acc[ai][bj][m][0] * oscale, v1 = acc[ai][bj][m][1] * oscale;
                        u32x4 w; w.x = cvt_pk_bf16(v0[0], v0[1]); w.y = cvt_pk_bf16(v0[2], v0[3]); w.z = cvt_pk_bf16(v1[0], v1[1]); w.w = cvt_pk_bf16(v1[2], v1[3]);
                        if (bj == 1 && O2 != nullptr) { const int r = row0 + ai * HALF + m * 16;
                            *(u32x4*)(O2 + ((size_t)((r >> 13) * MLA_H + u.pn) * SEQ + (r & (SEQ - 1))) * 128 + wc * 32 + 8 * fq) = w; }
                        else *(u32x4*)(rowp + bj * HALF) = w; } }
            return;
        }
        const int mg = 4 * wc + fq;
        u32x4 csv[2][4];
#pragma unroll
        for (int ai = 0; ai < 2; ++ai)
#pragma unroll
            for (int m = 0; m < 4; ++m) { const int r_ = row0 + ai * HALF + m * 16; csv[ai][m] = *(const u32x4*)(cs + ((size_t)((r_ >> 4) * 16 + mg) * 16 + (r_ & 15)) * 4); }
#pragma unroll
        for (int ai = 0; ai < 2; ++ai)
#pragma unroll
            for (int m = 0; m < 4; ++m)
#pragma unroll
                for (int bj = 0; bj < 2; ++bj) { const f32x4 a0 = acc[ai][bj][m][0], a1 = acc[ai][bj][m][1];
                    float s = (a0[0] * a0[0] + a0[1] * a0[1]) + (a0[2] * a0[2] + a0[3] * a0[3]) + (a1[0] * a1[0] + a1[1] * a1[1]) + (a1[2] * a1[2] + a1[3] * a1[3]);
                    s += __shfl_xor(s, 16); s += __shfl_xor(s, 32); s *= oscale * oscale;
                    if (fq == 0) xch[(((((wr * 2 + ai) * 4 + m) * 16 + fr) * 2 + bj) << 2) + wc] = s; }
        asm volatile("s_waitcnt lgkmcnt(0)" ::: "memory"); __builtin_amdgcn_s_barrier(); asm volatile("" ::: "memory");
        const float QSC = 0.08838834764831845f * 1.4426950408889634f;
#pragma unroll
        for (int bj = 0; bj < 2; ++bj) {
            const int hh = 2 * u.pn + bj, typ = (hh >> 4) % 3, grp = hh / 48;
            const int dsh = 2 * grp, lsh = 13 - dsh;
            bf16_t* hbase = O + (size_t)hh * SEQ * 128 + wc * 32 + 8 * fq;
#define ZROW(s_) ((size_t)((((s_) & ((1 << dsh) - 1)) << lsh) + ((s_) >> dsh)) * 128)
            if (typ == 2) {
#pragma unroll
                for (int ai = 0; ai < 2; ++ai)
#pragma unroll
                    for (int m = 0; m < 4; ++m) { const f32x4 v0 = acc[ai][bj][m][0] * oscale, v1 = acc[ai][bj][m][1] * oscale;
                        u32x4 w; w.x = cvt_pk_bf16(v0[0], v0[1]); w.y = cvt_pk_bf16(v0[2], v0[3]); w.z = cvt_pk_bf16(v1[0], v1[1]); w.w = cvt_pk_bf16(v1[2], v1[3]);
                        *(u32x4*)(hbase + ZROW(row0 + ai * HALF + m * 16)) = w; }
            } else {
                const float* gp = (typ == 0 ? g_qn : g_kn) + grp * 128 + 4 * mg; const float qs = typ == 0 ? QSC : 1.f;
                const f32x4 g1 = *(const f32x4*)gp * qs, g2 = *(const f32x4*)(gp + 64) * qs;
#pragma unroll
                for (int ai = 0; ai < 2; ++ai)
#pragma unroll
                    for (int m = 0; m < 4; ++m) { const int rl = ai * HALF + m * 16;
                        const f32x4 part = *(const LAS f32x4*)(xch + (((((wr * 2 + ai) * 4 + m) * 16 + fr) * 2 + bj) << 2));
                        const float rinv = rsqrtf(((part[0] + part[1]) + (part[2] + part[3])) * (1.f / 128) + 1e-6f) * oscale;
                        const u32x4 cw = csv[ai][m]; const f32x4 c4 = {bflo(cw.x), bflo(cw.y), bflo(cw.z), bflo(cw.w)}, s4 = {bfhi(cw.x), bfhi(cw.y), bfhi(cw.z), bfhi(cw.w)};
                        const f32x4 y1 = acc[ai][bj][m][0] * rinv * g1, y2 = acc[ai][bj][m][1] * rinv * g2;
                        const f32x4 o1 = y1 * c4 - y2 * s4, o2 = y2 * c4 + y1 * s4;
                        u32x4 w; w.x = cvt_pk_bf16(o1[0], o1[1]); w.y = cvt_pk_bf16(o1[2], o1[3]); w.z = cvt_pk_bf16(o2[0], o2[1]); w.w = cvt_pk_bf16(o2[2], o2[3]);
                        *(u32x4*)(hbase + ZROW(row0 + rl)) = w; }
            }
#undef ZROW
        }
    }
};
struct EpiResGate {
    static constexpr bool PERM = true;
    const float* base; const float* gate; int gate_bstride; bf16_t* out; int ldc; float oscale; int base_b16;
    __device__ __forceinline__ void operator()(const f32x4 (&acc)[2][2][4][2], const Unit& u, int wr, int wc, int fr, int fq) const {
        { const int l_ = otid() & 63; fr = l_ & 15; fq = l_ >> 4; }
        const int row0 = u.pm * BM + wr * 64 + fr, col0 = u.pn * BM + wc * 32 + 8 * fq;
        const float* gp = gate + (size_t)((u.pm * BM) / SEQ) * gate_bstride + col0;
        f32x4 gv[2][2];
#pragma unroll
        for (int bj = 0; bj < 2; ++bj)
#pragma unroll
            for (int n = 0; n < 2; ++n) gv[bj][n] = *(const f32x4*)(gp + bj * HALF + n * 4) * oscale;
#pragma unroll
        for (int ai = 0; ai < 2; ++ai) {
            f32x4 bs[4][2][2];
#pragma unroll
            for (int m = 0; m < 4; ++m) { const size_t off = (size_t)(row0 + ai * HALF + m * 16) * ldc + col0;
#pragma unroll
                for (int bj = 0; bj < 2; ++bj) {
                    if (base_b16) { const u32x4 w_ = *(const u32x4*)((const bf16_t*)base + off + bj * HALF);
                        bs[m][bj][0] = f32x4{bflo(w_.x), bfhi(w_.x), bflo(w_.y), bfhi(w_.y)}; bs[m][bj][1] = f32x4{bflo(w_.z), bfhi(w_.z), bflo(w_.w), bfhi(w_.w)}; }
                    else { bs[m][bj][0] = *(const f32x4*)(base + off + bj * HALF); bs[m][bj][1] = *(const f32x4*)(base + off + bj * HALF + 4); } } }
            asm volatile("" ::: "memory");
#pragma unroll
            for (int m = 0; m < 4; ++m) { const size_t off = (size_t)(row0 + ai * HALF + m * 16) * ldc + col0;
#pragma unroll
                for (int bj = 0; bj < 2; ++bj) { const f32x4 o0 = bs[m][bj][0] + gv[bj][0] * acc[ai][bj][m][0], o1 = bs[m][bj][1] + gv[bj][1] * acc[ai][bj][m][1];
                    *(u32x4*)(out + off + bj * HALF) = u32x4{cvt_pk_bf16(o0[0], o0[1]), cvt_pk_bf16(o0[2], o0[3]), cvt_pk_bf16(o1[0], o1[1]), cvt_pk_bf16(o1[2], o1[3])}; } }
            asm volatile("" ::: "memory"); }
    }
};
typedef int i32x8 __attribute__((ext_vector_type(8)));
typedef int i32x4v __attribute__((ext_vector_type(4)));
template <class Epi, class Sched, bool F8 = false>
__device__ __forceinline__ void gemm_phase(LAS unsigned char* lds, const Gemm g, const Sched& S, const Epi& E) {
    const int tid = otid(), wid = __builtin_amdgcn_readfirstlane(tid >> 6), lane = tid & 63, wr = wid >> 2, wc = wid & 3, fr = lane & 15, fq = lane >> 4;
    const int K = g.K, nt = K / BK;
    unsigned voffA[2], voffB[2];
#pragma unroll
    for (int i = 0; i < 2; ++i) { int R, C; stage_rc(tid * 16 + i * 8192, R, C); const int Rb = Epi::PERM ? ((R & ~31) + perm32(R & 31)) : R;
        voffA[i] = (unsigned)(R * K + C) * 2u; voffB[i] = (unsigned)(Rb * K + C) * 2u; }
    const size_t kstep = (size_t)(BK * 2);
    const size_t hstep = (size_t)HALF * K * 2;
    const size_t tstep = 2 * hstep;
    const unsigned ldsw = (unsigned)wid * 1024u;
    const int aoff = lds_byte(wr * 64 + fr, fq * 8), boff = lds_byte(wc * 32 + fr, fq * 8);
#define PG8_SA(b, h) (((b) * 2 + (h)) * HTB)
#define PG8_SB(b, h) ((4 + (b) * 2 + (h)) * HTB)
#define PG8_STAGE(bufoff, gbase, voff) do { _Pragma("unroll") for (int _i = 0; _i < 2; ++_i) \
        __builtin_amdgcn_global_load_lds((const unsigned*)((const char*)(gbase) + (voff)[_i]), (LAS unsigned*)(lds + (bufoff) + ldsw + _i * 8192), 16, 0, 0); } while (0)
#define PG8_LDA(dst, b, h) do { if constexpr (F8) { _Pragma("unroll") for (int m = 0; m < 4; ++m) { const i32x4v lo_ = *(const LAS i32x4v*)(lds + PG8_SA(b, h) + aoff + m * 2048), hi_ = *(const LAS i32x4v*)(lds + PG8_SA(b, h) + aoff + m * 2048 + 1024); \
            dst##8[m] = __builtin_shufflevector(lo_, hi_, 0, 1, 2, 3, 4, 5, 6, 7); } } \
        else { _Pragma("unroll") for (int m = 0; m < 4; ++m) _Pragma("unroll") for (int k = 0; k < 2; ++k) dst[m][k] = *(const LAS bf16x8*)(lds + PG8_SA(b, h) + aoff + m * 2048 + k * 1024); } } while (0)
#define PG8_LDB(dst, b, h) do { if constexpr (F8) { _Pragma("unroll") for (int n = 0; n < 2; ++n) { const i32x4v lo_ = *(const LAS i32x4v*)(lds + PG8_SB(b, h) + boff + n * 2048), hi_ = *(const LAS i32x4v*)(lds + PG8_SB(b, h) + boff + n * 2048 + 1024); \
            dst##8[n] = __builtin_shufflevector(lo_, hi_, 0, 1, 2, 3, 4, 5, 6, 7); } } \
        else { _Pragma("unroll") for (int n = 0; n < 2; ++n) _Pragma("unroll") for (int k = 0; k < 2; ++k) dst[n][k] = *(const LAS bf16x8*)(lds + PG8_SB(b, h) + boff + n * 2048 + k * 1024); } } while (0)
#define PG8_MMA(ai, bj, At, Bt) do { __builtin_amdgcn_s_setprio(1); _Pragma("unroll") for (int m = 0; m < 4; ++m) _Pragma("unroll") for (int n = 0; n < 2; ++n) { \
        if constexpr (F8) asm volatile("v_mfma_scale_f32_16x16x128_f8f6f4 %0, %1, %2, %0, %3, %3 op_sel_hi:[0,0,0]" : "+v"(acc[ai][bj][m][n]) : "v"(Bt##8[n]), "v"(At##8[m]), "v"(mxs));   \
        else { _Pragma("unroll") for (int k = 0; k < 2; ++k) acc[ai][bj][m][n] = __builtin_amdgcn_mfma_f32_16x16x32_bf16(Bt[n][k], At[m][k], acc[ai][bj][m][n], 0, 0, 0); } } \
        __builtin_amdgcn_s_setprio(0); } while (0)
#define PG8_WAIT_V(n) asm volatile("s_waitcnt vmcnt(" #n ")" ::: "memory")
#define PG8_WAIT_L(n) asm volatile("s_waitcnt lgkmcnt(" #n ")" ::: "memory")
#define PG8_BAR __builtin_amdgcn_s_barrier()
#define PG8_SCHED __builtin_amdgcn_sched_barrier(0)
    Unit cur, nxt; int ui = 0;
    if (!S.next(0, cur)) return;
    f32x4 acc[2][2][4][2];
#pragma unroll
    for (int a = 0; a < 2; ++a)
#pragma unroll
        for (int b = 0; b < 2; ++b)
#pragma unroll
            for (int m = 0; m < 4; ++m)
#pragma unroll
                for (int n = 0; n < 2; ++n) acc[a][b][m][n] = (f32x4){0.f, 0.f, 0.f, 0.f};
    bf16x8 At[4][2], B0[2][2], B1[2][2]; i32x8 At8[4], B08[2], B18[2];
    int mxs = 0x7F7F7F7F; asm volatile("" : "+v"(mxs));
    const char* cA = (const char*)g.A + (size_t)cur.pm * tstep; const char* cB = (const char*)g.Bt + (size_t)cur.pn * tstep;
    S.a_ready(cur);
    PG8_STAGE(PG8_SB(0, 0), cB, voffB); PG8_STAGE(PG8_SA(0, 0), cA, voffA); PG8_STAGE(PG8_SB(0, 1), cB + hstep, voffB); PG8_STAGE(PG8_SA(0, 1), cA + hstep, voffA);
    if (wr == 1) PG8_BAR;
    PG8_WAIT_V(4); PG8_BAR;
    PG8_STAGE(PG8_SB(1, 0), cB + kstep, voffB); PG8_STAGE(PG8_SA(1, 0), cA + kstep, voffA); PG8_STAGE(PG8_SB(1, 1), cB + hstep + kstep, voffB);
    PG8_WAIT_V(6); PG8_BAR;
    for (;;) {
        const bool has_next = S.next(ui + 1, nxt);
        const char* nA = has_next ? (const char*)g.A + (size_t)nxt.pm * tstep : cA; const char* nB = has_next ? (const char*)g.Bt + (size_t)nxt.pn * tstep : cB;
        for (int t = 0; t < nt; t += 2) {
            const bool last = (t == nt - 2);
            const char* a1 = cA + (size_t)(t + 1) * kstep;
            const char* a2 = last ? nA : cA + (size_t)(t + 2) * kstep; const char* b2 = last ? nB : cB + (size_t)(t + 2) * kstep;
            const char* a3 = a2 + kstep; const char* b3 = b2 + kstep;
            if (last && has_next) S.a_ready(nxt);
            PG8_LDB(B0, 0, 0); PG8_SCHED; PG8_LDA(At, 0, 0); PG8_STAGE(PG8_SA(1, 1), a1 + hstep, voffA);
            PG8_WAIT_L(8); PG8_BAR; PG8_WAIT_L(0); PG8_MMA(0, 0, At, B0); PG8_BAR; PG8_SCHED;
            PG8_LDB(B1, 0, 1); PG8_STAGE(PG8_SB(0, 0), b2, voffB);
            PG8_BAR; PG8_WAIT_L(0); PG8_MMA(0, 1, At, B1); PG8_BAR;
            PG8_LDA(At, 0, 1); PG8_STAGE(PG8_SA(0, 0), a2, voffA);
            PG8_BAR; PG8_WAIT_L(0); PG8_MMA(1, 0, At, B0); PG8_BAR; PG8_SCHED;
            PG8_STAGE(PG8_SB(0, 1), b2 + hstep, voffB);
            PG8_WAIT_V(6); PG8_BAR; PG8_MMA(1, 1, At, B1); PG8_BAR;
            PG8_LDB(B0, 1, 0); PG8_SCHED; PG8_LDA(At, 1, 0); PG8_STAGE(PG8_SA(0, 1), a2 + hstep, voffA);
            PG8_WAIT_L(8); PG8_BAR; PG8_WAIT_L(0); PG8_MMA(0, 0, At, B0); PG8_BAR; PG8_SCHED;
            PG8_LDB(B1, 1, 1); PG8_STAGE(PG8_SB(1, 0), b3, voffB);
            PG8_BAR; PG8_WAIT_L(0); PG8_MMA(0, 1, At, B1); PG8_BAR;
            PG8_LDA(At, 1, 1); PG8_STAGE(PG8_SA(1, 0), a3, voffA);
            PG8_BAR; PG8_WAIT_L(0); PG8_MMA(1, 0, At, B0); PG8_BAR; PG8_SCHED;
            PG8_STAGE(PG8_SB(1, 1), b3 + hstep, voffB);
            PG8_WAIT_V(6); PG8_BAR; PG8_MMA(1, 1, At, B1); PG8_BAR;
        }
        if (wr == 0) PG8_BAR;
        if constexpr (F8) asm volatile("s_nop 15\n\ts_nop 15" ::: "memory");
        E(acc, cur, wr, wc, fr, fq); S.done(cur);
        if (!has_next) break;
#pragma unroll
        for (int a = 0; a < 2; ++a)
#pragma unroll
            for (int b = 0; b < 2; ++b)
#pragma unroll
                for (int m = 0; m < 4; ++m)
#pragma unroll
                    for (int n = 0; n < 2; ++n) acc[a][b][m][n] = (f32x4){0.f, 0.f, 0.f, 0.f};
        cur = nxt; cA = nA; cB = nB; ++ui;
        if (wr == 1) PG8_BAR;
    }
    PG8_WAIT_V(0);
    PG8_BAR;
#undef PG8_SA
#undef PG8_SB
#undef PG8_STAGE
#undef PG8_LDA
#undef PG8_LDB
#undef PG8_MMA
#undef PG8_WAIT_V
#undef PG8_WAIT_L
#undef PG8_BAR
#undef PG8_SCHED
}
}

namespace at {
constexpr int SHM_V = 64 * 128 * 2;
constexpr float THR = 8.f;
#define SBAR() __builtin_amdgcn_sched_barrier(0)
__device__ __forceinline__ int v_st(int k, int c) { const int kk = (k & ~0xC) | ((k & 4) << 1) | ((k & 8) >> 1); return ((kk >> 3) * 4 + (c >> 5)) * 512 + ((kk & 7) * 32 + (c & 31)) * 2; }
__device__ __forceinline__ int v_rd_base(int lane) { return ((lane & 3) << 3) | (((lane >> 2) & 3) << 6) | (((lane >> 4) & 1) << 5) | (((lane >> 5) & 1) << 8); }
constexpr int v_rd_off(int d0, int ks, int half) { return d0 * 512 + ks * 4096 + half * 2048; }
__device__ __forceinline__ int crow(int r, int hi) { return (r & 3) + 8 * (r >> 2) + 4 * hi; }
__device__ __forceinline__ void mask_tile(f32x16& p0, f32x16& p1, int dq, unsigned W) {
    const float NEG = -__builtin_inff();
#pragma unroll
    for (int r = 0; r < 16; ++r) {
        const int c = (r & 3) + 8 * (r >> 2);
        if ((unsigned)(dq - c) >= W) p0[r] = NEG;
        if ((unsigned)(dq - c - 32) >= W) p1[r] = NEG;
    }
}
__device__ __forceinline__ void partialSM(f32x16& p0, f32x16& p1, float& m_reg, float& alpha) {
    float pmax = p0[0];
#pragma unroll
    for (int r = 1; r < 16; ++r) pmax = fmaxf(pmax, p0[r]);
#pragma unroll
    for (int r = 0; r < 16; ++r) pmax = fmaxf(pmax, p1[r]);
    { auto rr = __builtin_amdgcn_permlane32_swap(__float_as_uint(pmax), __float_as_uint(pmax), false, false);
      pmax = fmaxf(__uint_as_float(rr[0]), __uint_as_float(rr[1])); }
    float mn;
    if (__builtin_expect(__all((pmax - m_reg) <= THR), 1)) { mn = m_reg; alpha = 1.f; }
    else { mn = fmaxf(m_reg, pmax); alpha = __builtin_amdgcn_exp2f(m_reg - mn); m_reg = mn; }
#pragma unroll
    for (int r = 0; r < 16; ++r) p0[r] = __builtin_amdgcn_exp2f(p0[r] - mn);
#pragma unroll
    for (int r = 0; r < 16; ++r) p1[r] = __builtin_amdgcn_exp2f(p1[r] - mn);
}
__device__ __forceinline__ void finishSM(f32x16& p0, f32x16& p1, float alpha, float& l_reg, bf16x8& pa0, bf16x8& pa1, bf16x8& pa2, bf16x8& pa3) {
    float ps = 0;
#pragma unroll
    for (int r = 0; r < 16; ++r) ps += p0[r];
#pragma unroll
    for (int r = 0; r < 16; ++r) ps += p1[r];
    { auto rr = __builtin_amdgcn_permlane32_swap(__float_as_uint(ps), __float_as_uint(ps), false, false);
      ps = __uint_as_float(rr[0]) + __uint_as_float(rr[1]); }
    l_reg = l_reg * alpha + ps;
#define PK4(P, B_, OUT) do { unsigned a0 = cvt_pk_bf16(P[B_+0], P[B_+1]), a1 = cvt_pk_bf16(P[B_+2], P[B_+3]);                          \
        unsigned b0 = cvt_pk_bf16(P[B_+4], P[B_+5]), b1 = cvt_pk_bf16(P[B_+6], P[B_+7]);                                             \
        auto r0 = __builtin_amdgcn_permlane32_swap(a0, b0, false, false); auto r1 = __builtin_amdgcn_permlane32_swap(a1, b1, false, false); \
        u32x4 w = {r0[0], r1[0], r0[1], r1[1]}; OUT = *reinterpret_cast<bf16x8*>(&w); } while (0)
    PK4(p0, 0, pa0); PK4(p0, 8, pa1); PK4(p1, 0, pa2); PK4(p1, 8, pa3);
#undef PK4
}
template <int KP, int ND>
__device__ __forceinline__ void qkt(f32x16& p0, f32x16& p1, const LAS char* Kb, int r32, int hi, const bf16x8* qr) {
    p0 = f32x16{}; p1 = f32x16{};
    __builtin_amdgcn_s_setprio(1);
    const LAS char* ka = Kb + r32 * KP + hi * 16;
#pragma unroll
    for (int d0 = 0; d0 < ND; ++d0) {
        const bf16x8 b0 = *reinterpret_cast<const LAS bf16x8*>(ka + d0 * 32);
        const bf16x8 b1 = *reinterpret_cast<const LAS bf16x8*>(ka + 32 * KP + d0 * 32);
        p0 = __builtin_amdgcn_mfma_f32_32x32x16_bf16(b0, qr[d0], p0, 0, 0, 0);
        p1 = __builtin_amdgcn_mfma_f32_32x32x16_bf16(b1, qr[d0], p1, 0, 0, 0);
        if ((d0 & 3) == 3) SBAR(); }
    __builtin_amdgcn_s_setprio(0);
}
template <int VB>
__device__ __forceinline__ void pv_tile(f32x16* o, int vb0, bf16x8 pa0, bf16x8 pa1, bf16x8 pa2, bf16x8 pa3) {
#define TRRD(dst, off) asm volatile("ds_read_b64_tr_b16 %0, %1 offset:%2" : "=&v"(dst) : "v"(vb0), "i"(off) : "memory")
#define PV_D0(d0) do { s16x4 l0, l1, l2, l3, h0, h1, h2, h3; constexpr int b_ = VB * SHM_V + v_rd_off(d0, 0, 0); \
        TRRD(l0, b_); TRRD(h0, b_ + 2048); TRRD(l1, b_ + 4096); TRRD(h1, b_ + 6144); TRRD(l2, b_ + 8192); TRRD(h2, b_ + 10240); TRRD(l3, b_ + 12288); TRRD(h3, b_ + 14336); \
        asm volatile("s_waitcnt lgkmcnt(0)" ::: "memory"); SBAR();   \
        o[d0] = __builtin_amdgcn_mfma_f32_32x32x16_bf16(pa0, (bf16x8){l0[0], l0[1], l0[2], l0[3], h0[0], h0[1], h0[2], h0[3]}, o[d0], 0, 0, 0);   \
        o[d0] = __builtin_amdgcn_mfma_f32_32x32x16_bf16(pa1, (bf16x8){l1[0], l1[1], l1[2], l1[3], h1[0], h1[1], h1[2], h1[3]}, o[d0], 0, 0, 0);   \
        o[d0] = __builtin_amdgcn_mfma_f32_32x32x16_bf16(pa2, (bf16x8){l2[0], l2[1], l2[2], l2[3], h2[0], h2[1], h2[2], h2[3]}, o[d0], 0, 0, 0);   \
        o[d0] = __builtin_amdgcn_mfma_f32_32x32x16_bf16(pa3, (bf16x8){l3[0], l3[1], l3[2], l3[3], h3[0], h3[1], h3[2], h3[3]}, o[d0], 0, 0, 0); } while (0)
    PV_D0(0); PV_D0(1); PV_D0(2); PV_D0(3);
#undef PV_D0
#undef TRRD
}
struct Item { const bf16_t* Q; const bf16_t* K; const bf16_t* V; bf16_t* O; float* LSE; long qs, ks, vs, os, ls; int i0, W, L, o_f8; };
template <int DQK>
__device__ __forceinline__ void attn_block(const Item& it, LAS char* lds) {
    constexpr int KP = DQK * 2 + 16, KBYTES = 64 * KP, ND = DQK / 16, CPR = DQK / 8, NKC = (64 * CPR) / 512;
    const int tid = otid(), wid = __builtin_amdgcn_readfirstlane(tid >> 6), lane = tid & 63, r32 = lane & 31, hi = lane >> 5;
    LAS char* V_lds = lds; LAS char* K_lds = lds + 3 * SHM_V;
    LAS float* wsf = (LAS float*)(lds + 3 * SHM_V + 3 * KBYTES) + wid * 64; LAS float* li_l = wsf; LAS float* al_l = wsf + 32;
    const int W = it.W, i0 = it.i0;
    const int qlo = i0 + wid * 32, qm = qlo + r32 - 4 * hi;
    const int lowk = i0 - (W - 1); const int j_lo = lowk > 0 ? lowk / 64 : 0;
    int j_hi = (i0 + 255) / 64 + 1; if (j_hi > it.L / 64) j_hi = it.L / 64;
    const int NT = j_hi - j_lo;
    bf16x8 qr[ND];
    { const bf16_t* qrow = it.Q + (size_t)(qlo + r32) * it.qs + hi * 8;
#pragma unroll
      for (int d0 = 0; d0 < ND; ++d0) qr[d0] = *reinterpret_cast<const bf16x8*>(qrow + d0 * 16); }
    unsigned kgo[NKC], klo[NKC];
#pragma unroll
    for (int i = 0; i < NKC; ++i) { const int c = tid + 512 * i, kr_ = c / CPR, kc_ = c % CPR; kgo[i] = (unsigned)(kr_ * (int)it.ks * 2 + kc_ * 16); klo[i] = (unsigned)(kr_ * KP + kc_ * 16); }
    const int sr = tid >> 4, sc = (tid & 15) * 8, vst0 = v_st(sr, sc), vst1 = v_st(32 + sr, sc);
    const unsigned vgo0 = (unsigned)(sr * (int)it.vs * 2 + sc * 2), vgo1 = (unsigned)((32 + sr) * (int)it.vs * 2 + sc * 2);
    const int vb0 = (int)(uintptr_t)V_lds + v_rd_base(lane);
    bf16x8 stK[NKC], stV0, stV1;
#define AT_LOAD(t) do { const char* kt_ = (const char*)it.K + (size_t)(j_lo + (t)) * 64 * it.ks * 2; const char* vt_ = (const char*)it.V + (size_t)(j_lo + (t)) * 64 * it.vs * 2; \
        _Pragma("unroll") for (int i = 0; i < NKC; ++i) stK[i] = *reinterpret_cast<const bf16x8*>(kt_ + (size_t)kgo[i]); \
        stV0 = *reinterpret_cast<const bf16x8*>(vt_ + (size_t)vgo0); stV1 = *reinterpret_cast<const bf16x8*>(vt_ + (size_t)vgo1); } while (0)
#define AT_WRITE(bf) do { _Pragma("unroll") for (int i = 0; i < NKC; ++i) *reinterpret_cast<LAS bf16x8*>(K_lds + (bf) * KBYTES + klo[i]) = stK[i]; \
        *reinterpret_cast<LAS bf16x8*>(V_lds + (bf) * SHM_V + vst0) = stV0; *reinterpret_cast<LAS bf16x8*>(V_lds + (bf) * SHM_V + vst1) = stV1; } while (0)
    float m_reg = -1e30f, l_reg = 0.f; f32x16 o[4] = {};
    const bool late = wid >= 4;
    f32x16 p0, p1; bool pend = false;
#define AT_PRO() do { AT_LOAD(0); AT_WRITE(0); if (NT > 1) AT_LOAD(1); __syncthreads(); } while (0)
#define AT_SMPV(BFV) do { float alpha; bf16x8 pa0, pa1, pa2, pa3; \
        partialSM(p0, p1, m_reg, alpha); \
        if (__any(alpha < 1.f)) { if (hi == 0) al_l[r32] = alpha; asm volatile("s_waitcnt lgkmcnt(0)" ::: "memory"); \
            _Pragma("unroll") for (int d_ = 0; d_ < 4; ++d_) _Pragma("unroll") for (int r = 0; r < 16; ++r) o[d_][r] *= al_l[crow(r, hi)]; } \
        finishSM(p0, p1, alpha, l_reg, pa0, pa1, pa2, pa3); SBAR(); \
        pv_tile<BFV>(o, vb0, pa0, pa1, pa2, pa3); } while (0)
#define AT_QK(t, BF) do { const int kb = (j_lo + (t)) * 64; \
        qkt<KP, ND>(p0, p1, K_lds + (BF) * KBYTES, r32, hi, qr); \
        if (kb + 63 > qlo || kb <= qlo + 31 - W) mask_tile(p0, p1, qm - kb, (unsigned)W); } while (0)
#define AT_ACTIVE(t) ((j_lo + (t)) * 64 <= qlo + 31 && (j_lo + (t)) * 64 + 63 >= qlo - (W - 1))
#define AT_STAGE(t, BFN) do { if ((t) + 1 < NT) { AT_WRITE(BFN); if ((t) + 2 < NT) AT_LOAD((t) + 2); } } while (0)
    if (!late) {
        asm volatile("; early half" ::: "memory"); AT_PRO();
#define AT_STEP(t, BF, BFN) do { AT_STAGE(t, BFN); if (AT_ACTIVE(t)) { AT_QK(t, BF); AT_SMPV(BF); } __syncthreads(); } while (0)
        for (int t = 0; t < NT; t += 3) {
            AT_STEP(t, 0, 1);
            if (t + 1 < NT) AT_STEP(t + 1, 1, 2);
            if (t + 2 < NT) AT_STEP(t + 2, 2, 0);
        }
#undef AT_STEP
    } else {
        asm volatile("; late half" ::: "memory"); AT_PRO();
#define AT_STEP(t, BF, BFN, BFP) do { AT_STAGE(t, BFN); if (pend) { AT_SMPV(BFP); } pend = AT_ACTIVE(t); if (pend) { AT_QK(t, BF); } __syncthreads(); } while (0)
        for (int t = 0; t < NT; t += 3) {
            AT_STEP(t, 0, 1, 2);
            if (t + 1 < NT) AT_STEP(t + 1, 1, 2, 0);
            if (t + 2 < NT) AT_STEP(t + 2, 2, 0, 1);
        }
#undef AT_STEP
        if (pend) { const int lastslot = (NT - 1) % 3;
            if (lastslot == 0) AT_SMPV(0); else if (lastslot == 1) AT_SMPV(1); else AT_SMPV(2); }
    }
#undef AT_STAGE
#undef AT_PRO
#undef AT_SMPV
#undef AT_QK
#undef AT_ACTIVE
#undef AT_STEP
#undef AT_LOAD
#undef AT_WRITE
    __syncthreads();
    if (hi == 0) li_l[r32] = l_reg;
    asm volatile("s_waitcnt lgkmcnt(0)" ::: "memory");
    LAS char* ow = lds + wid * 8192;
#pragma unroll
    for (int r = 0; r < 16; ++r) { const int orow = crow(r, hi); const float rl = __builtin_amdgcn_rcpf(li_l[orow]);
#pragma unroll
        for (int d0 = 0; d0 < 4; ++d0) { const float v = o[d0][r] * rl; const float vn = __shfl_xor(v, 1);
            if ((r32 & 1) == 0) *reinterpret_cast<LAS unsigned*>(ow + orow * 256 + (d0 * 32 + r32) * 2) = cvt_pk_bf16(v, vn); } }
    asm volatile("s_waitcnt lgkmcnt(0)" ::: "memory");
#pragma unroll
    for (int k = 0; k < 8; ++k) { const int row = k * 4 + (lane >> 4), ch = lane & 15;
        const u32x4 w = *reinterpret_cast<const LAS u32x4*>(ow + row * 256 + ch * 16);
        if (it.o_f8) { float f[8]; unpack8(w, f);
            int q0 = __builtin_amdgcn_cvt_pk_fp8_f32(f[0] * ACT_F8SCALE, f[1] * ACT_F8SCALE, 0, false); q0 = __builtin_amdgcn_cvt_pk_fp8_f32(f[2] * ACT_F8SCALE, f[3] * ACT_F8SCALE, q0, true);
            int q1 = __builtin_amdgcn_cvt_pk_fp8_f32(f[4] * ACT_F8SCALE, f[5] * ACT_F8SCALE, 0, false); q1 = __builtin_amdgcn_cvt_pk_fp8_f32(f[6] * ACT_F8SCALE, f[7] * ACT_F8SCALE, q1, true);
            u32x2 w8 = {(unsigned)q0, (unsigned)q1}; *(u32x2*)((unsigned char*)it.O + (size_t)(qlo + row) * it.os + ch * 8) = w8; }
        else *(u32x4*)(it.O + (size_t)(qlo + row) * it.os + ch * 8) = w; }
    if (it.LSE != nullptr && hi == 0) it.LSE[(size_t)(qlo + r32) * it.ls] = m_reg + __builtin_amdgcn_logf(l_reg);
    __syncthreads();
}
}

struct Args {
    const float* x; const float* c; const int* pos; const float* ada_w; const float* ada_b; const float* norm_g;
    const float* mla_w_in; const float* mla_g_q; const float* mla_w_uq; const float* mla_g_kv; const float* mla_w_ukv; const float* mla_g_qn; const float* mla_g_kn; const float* mla_w_o;
    const float* dil_w_in; const float* dil_g_qn; const float* dil_g_kn; const float* dil_w_o;
    const float* peer_w_q; const float* peer_sub_keys; const float* peer_u; const float* peer_v;
    float* out; unsigned char* ws; int ph_lo, ph_hi;
};
constexpr int LDS_MAIN = 128 * 1024, LDS_XCH = LDS_MAIN + 1024, LDS_BYTES = LDS_XCH + 8192;

struct TrJob { const float* src; bf16_t* dst; int K, N, Npad; int perm; float f8scale; };
__device__ __forceinline__ void tr_load(const TrJob& j, int u, int ntk, int tid, f32x4 (&v)[4]) {
    const int k0 = (u % ntk) * 128, n0 = (u / ntk) * 64, r = tid >> 4, c4 = (tid & 15) * 4;
    int sc = n0 + c4;
    if (j.perm && ((sc >> 11) % 3) < 2) { const int p = sc & 127, mgrp = p >> 3; sc = (sc & ~127) + ((p & 4) ? 64 + 4 * mgrp : 4 * mgrp); }
#pragma unroll
    for (int q2 = 0; q2 < 4; ++q2) { v[q2] = (f32x4){0.f, 0.f, 0.f, 0.f}; if (n0 + c4 < j.N) v[q2] = __builtin_nontemporal_load((const f32x4*)(j.src + (size_t)(k0 + r + 32 * q2) * j.N + sc)); }
}
__device__ __forceinline__ void transpose_job(const TrJob& j, int u0, int G, LAS float* tile) {
    const int tid = otid(); const int ntk = j.K / 128, nt = ntk * (j.Npad / 64);
    if (u0 >= nt) return;
    f32x4 v[4]; tr_load(j, u0, ntk, tid, v);
    for (int u = u0; u < nt; u += G) {
        const int k0 = (u % ntk) * 128, n0 = (u / ntk) * 64;
        { const int r = tid >> 4, c4 = (tid & 15) * 4;
#pragma unroll
          for (int q2 = 0; q2 < 4; ++q2) { const int rr = r + 32 * q2; tile[rr * 65 + c4 + 0] = v[q2][0]; tile[rr * 65 + c4 + 1] = v[q2][1]; tile[rr * 65 + c4 + 2] = v[q2][2]; tile[rr * 65 + c4 + 3] = v[q2][3]; } }
        __syncthreads();
        if (u + G < nt) tr_load(j, u + G, ntk, tid, v);
        { const int n = tid >> 3, k16 = (tid & 7) * 16; float f[16];
#pragma unroll
          for (int e = 0; e < 16; ++e) f[e] = tile[(k16 + e) * 65 + n];
          if (j.f8scale != 0.f) { const float sc_ = j.f8scale; unsigned p[4];
#pragma unroll
              for (int q = 0; q < 4; ++q) { int t_ = __builtin_amdgcn_cvt_pk_fp8_f32(f[4 * q] * sc_, f[4 * q + 1] * sc_, 0, false); t_ = __builtin_amdgcn_cvt_pk_fp8_f32(f[4 * q + 2] * sc_, f[4 * q + 3] * sc_, t_, true); p[q] = (unsigned)t_; }
              *(u32x4*)((unsigned char*)j.dst + (size_t)(n0 + n) * j.K + k0 + k16) = u32x4{p[0], p[1], p[2], p[3]}; }
          else { u32x4 w0 = {cvt_pk_bf16(f[0], f[1]), cvt_pk_bf16(f[2], f[3]), cvt_pk_bf16(f[4], f[5]), cvt_pk_bf16(f[6], f[7])}, w1 = {cvt_pk_bf16(f[8], f[9]), cvt_pk_bf16(f[10], f[11]), cvt_pk_bf16(f[12], f[13]), cvt_pk_bf16(f[14], f[15])};
              *(u32x4*)(j.dst + (size_t)(n0 + n) * j.K + k0 + k16) = w0; *(u32x4*)(j.dst + (size_t)(n0 + n) * j.K + k0 + k16 + 8) = w1; } }
        __syncthreads();
    }
}
__device__ __forceinline__ void convert_flat(const float* src, bf16_t* dst, size_t n, size_t i0, size_t stride) {
    for (size_t i = i0 * 8; i < n; i += stride * 8) { const f32x4 a = *(const f32x4*)(src + i), b = *(const f32x4*)(src + i + 4); *(u32x4*)(dst + i) = pack8f(a, b); }
}
__device__ __forceinline__ void prologue_phase(const Args& A, LAS unsigned char* lds) {
    const int tid = otid(), G = gridDim.x, bid = obid();
    unsigned char* ws = A.ws;
    { LAS float* sl = (LAS float*)lds;
      LAS float* part = sl + 2 * DM;
      float* MOD = (float*)(ws + WS_CTL + CTL_MOD_OFF);
      for (int u = bid; u < 2 * 96; u += G) {
          const int l = u / 96, cc = u % 96;
          __syncthreads();
          for (int i = tid; i < 2 * DM; i += 512) { const float v = A.c[i]; sl[i] = v / (1.f + __expf(-v)); }
          __syncthreads();
          const int c4 = tid & 31, dg = tid >> 5; const int col = cc * 128 + 4 * c4;
          f32x4 a0 = {0.f, 0.f, 0.f, 0.f}, a1 = {0.f, 0.f, 0.f, 0.f};
          const float* wp = A.ada_w + ((size_t)l * DM + dg) * (6 * DM) + col;
#pragma unroll 1
          for (int i0 = 0; i0 < 128; i0 += 16) {
              f32x4 w[16];
#pragma unroll
              for (int k = 0; k < 16; ++k) w[k] = __builtin_nontemporal_load((const f32x4*)(wp + (size_t)(i0 + k) * 16 * (6 * DM)));
#pragma unroll
              for (int k = 0; k < 16; ++k) { const int d = dg + 16 * (i0 + k); a0 += w[k] * sl[d]; a1 += w[k] * sl[DM + d]; }
          }
          *(LAS f32x4*)(part + (dg * 2 + 0) * 128 + 4 * c4) = a0; *(LAS f32x4*)(part + (dg * 2 + 1) * 128 + 4 * c4) = a1;
          __syncthreads();
          if (tid < 256) { const int b = tid >> 7, cq = tid & 127; float s = A.ada_b[l * 6 * DM + cc * 128 + cq];
#pragma unroll
              for (int g2 = 0; g2 < 16; ++g2) s += part[(g2 * 2 + b) * 128 + cq];
              MOD[((size_t)l * 2 + b) * 6 * DM + cc * 128 + cq] = s; }
      }
      __syncthreads(); }
    { int base = 0;
#define TR_JOB(SRC, DST, KK, NN, NP, PM, F8S) do { TrJob j; j.src = (SRC); j.dst = (DST); j.K = (KK); j.N = (NN); j.Npad = (NP); j.perm = (PM); j.f8scale = (F8S); const int nt = (j.K / 128) * (j.Npad / 64); \
          int u = bid - (base % G); if (u < 0) u += G; transpose_job(j, u, G, (LAS float*)lds); base += nt; } while (0)
      TR_JOB(A.mla_w_in, (bf16_t*)(ws + WS_WIN_MLA), DM, MLA_IN, MLA_IN_PAD, 0, DIL_WSCALE);
      TR_JOB(A.mla_w_uq, (bf16_t*)(ws + WS_WUQ), 512, 3072, 3072, 0, DIL_WSCALE);
      TR_JOB(A.mla_w_ukv, (bf16_t*)(ws + WS_WUKV), 512, 4096, 4096, 0, DIL_WSCALE);
      TR_JOB(A.mla_w_o, (bf16_t*)(ws + WS_WO_MLA), DM, DM, DM, 0, DIL_WSCALE);
      TR_JOB(A.dil_w_in, (bf16_t*)(ws + WS_WIN_DIL), DM, DIL_IN, DIL_IN, 1, DIL_WSCALE);
      TR_JOB(A.dil_w_o, (bf16_t*)(ws + WS_WO_DIL), DM, DM, DM, 0, DIL_WSCALE);
      TR_JOB(A.peer_w_q, (bf16_t*)(ws + WS_WQ), DM, DM, DM, 0, 0.f);
      TR_JOB(A.peer_w_q + (size_t)DM * DM, (bf16_t*)(ws + WS_WQ) + (size_t)DM * DM, DM, DM, DM, 0, 0.f);
#undef TR_JOB
    }
    { const size_t i0 = (size_t)bid * 512 + tid, stride = (size_t)G * 512;
      { bf16_t* sk = (bf16_t*)(ws + WS_SUBK);
        for (size_t i = i0 * 8; i < (size_t)2 * 8 * 2 * 128 * 128; i += stride * 8) { const f32x4 a = *(const f32x4*)(A.peer_sub_keys + i), b = *(const f32x4*)(A.peer_sub_keys + i + 4);
            const size_t blk = i >> 14; const int w_ = (int)(i & 16383), key = w_ >> 7, d0 = w_ & 127;
            const size_t o_ = (blk << 14) + (size_t)((((key >> 5) * 8 + (d0 >> 4)) * 64 + ((d0 >> 3) & 1) * 32 + (key & 31)) * 8);
            *(u32x4*)(sk + o_) = pack8f(a, b); } }
      unsigned* csT = (unsigned*)(ws + WS_ROPE);
      for (size_t i = i0; i < (size_t)T * 64; i += stride) { const int tok = (int)(i >> 6), fi = (int)(i & 63); const float inv = exp2f(-(float)fi * (13.287712379549449f / 64.f));
          float s_, c_; sincos_rev((float)A.pos[tok] * inv, s_, c_); csT[(((size_t)(tok >> 4) * 16 + (fi >> 2)) * 16 + (tok & 15)) * 4 + (fi & 3)] = bf16_rne_bits(c_) | (bf16_rne_bits(s_) << 16); } }
}
__device__ __forceinline__ void table_row_store(const f32x4 (&v)[8], float mx, int e, unsigned char* __restrict__ dst, float* __restrict__ scales, int lane) {
#pragma unroll
    for (int o = 32; o >= 1; o >>= 1) mx = fmaxf(mx, __shfl_xor(mx, o));
    const int ex = (int)((__float_as_uint(mx) >> 23) & 0xff);
    const float scale = ex == 0 ? 1.f : __uint_as_float((unsigned)(ex - 7 > 1 ? ex - 7 : 1) << 23);
    const float inv = 1.f / scale;
    if (lane == 0) scales[e] = scale;
#pragma unroll
    for (int k = 0; k < 8; ++k) { int p = __builtin_amdgcn_cvt_pk_fp8_f32(v[k][0] * inv, v[k][1] * inv, 0, false); p = __builtin_amdgcn_cvt_pk_fp8_f32(v[k][2] * inv, v[k][3] * inv, p, true);
        const int c = 2 * k + (lane >> 5); *(int*)(dst + ((size_t)c * PEER_E + e) * 128 + 4 * (lane & 31)) = p; }
}
__device__ __forceinline__ void table_row_store4(const f32x4 (&v)[8], float mx, float ss, int e, unsigned char* __restrict__ dst, float* __restrict__ scales, int lane) {
#pragma unroll
    for (int o = 32; o >= 1; o >>= 1) { mx = fmaxf(mx, __shfl_xor(mx, o)); ss += __shfl_xor(ss, o); }
    float scale = fmaxf(sqrtf(ss * (1.f / DM)) * (1.f / 2.1f), mx * 0.125f);
    if (!(scale > 0.f)) scale = 1.f;
    const float inv = 1.f / scale;
    if (lane == 0) scales[2 * e] = scale;
#pragma unroll
    for (int k = 0; k < 8; ++k) { unsigned p = __builtin_amdgcn_cvt_scalef32_pk_fp4_f32(0u, v[k][0] * inv, v[k][1] * inv, 1.0f, 0); p = __builtin_amdgcn_cvt_scalef32_pk_fp4_f32(p, v[k][2] * inv, v[k][3] * inv, 1.0f, 1);
        *(unsigned short*)(dst + ((size_t)k * PEER_E + e) * 128 + 2 * lane) = (unsigned short)p; }
}
__device__ __forceinline__ void table_rows_fp8(const float* __restrict__ src, unsigned char* __restrict__ dst, float* __restrict__ scales, int bid, int nb, int wv, int lane, bool f4) {
    for (int run = bid; run < PEER_E / 64; run += nb) {
#pragma unroll 1
        for (int i = 0; i < 8; i += 2) {
            const int e0 = run * 64 + wv * 8 + i, e1 = e0 + 1;
            f32x4 va[8], vb[8]; float ma = 0.f, mb = 0.f;
#pragma unroll
            for (int k = 0; k < 8; ++k) { va[k] = __builtin_nontemporal_load((const f32x4*)(src + (size_t)e0 * DM + k * 256 + lane * 4)); vb[k] = __builtin_nontemporal_load((const f32x4*)(src + (size_t)e1 * DM + k * 256 + lane * 4)); }
#pragma unroll
            for (int k = 0; k < 8; ++k) { ma = fmaxf(ma, fmaxf(fmaxf(fabsf(va[k][0]), fabsf(va[k][1])), fmaxf(fabsf(va[k][2]), fabsf(va[k][3])))); mb = fmaxf(mb, fmaxf(fmaxf(fabsf(vb[k][0]), fabsf(vb[k][1])), fmaxf(fabsf(vb[k][2]), fabsf(vb[k][3])))); }
            if (f4) { float sa_ = 0.f, sb_ = 0.f;
#pragma unroll
                for (int k = 0; k < 8; ++k) { sa_ += (va[k][0] * va[k][0] + va[k][1] * va[k][1]) + (va[k][2] * va[k][2] + va[k][3] * va[k][3]); sb_ += (vb[k][0] * vb[k][0] + vb[k][1] * vb[k][1]) + (vb[k][2] * vb[k][2] + vb[k][3] * vb[k][3]); }
                table_row_store4(va, ma, sa_, e0, dst, scales, lane); table_row_store4(vb, mb, sb_, e1, dst, scales, lane); }
            else { table_row_store(va, ma, e0, dst, scales, lane); table_row_store(vb, mb, e1, dst, scales, lane); }
        }
    }
}
__device__ __forceinline__ void tables_phase(const float* u, const float* v, unsigned char* U, unsigned char* V, float* usc, float* vsc) {
    const int tid_ = otid(), lane = tid_ & 63, wv = tid_ >> 6, bid = obid(), nb = gridDim.x;
    table_rows_fp8(u, U, usc, bid, nb, wv, lane, true); table_rows_fp8(v, V, vsc, bid, nb, wv, lane, true);
}

__device__ __forceinline__ void norm_phase(const float* __restrict__ xin, const float* __restrict__ gain, const float* __restrict__ modl  , int shift_off, int scale_off, bf16_t* __restrict__ out, int f8  , unsigned char* __restrict__ out8b = nullptr  , int inb16 = 0  ) {
    const int tid_ = otid(), lane = tid_ & 63, gw = obid() * 8 + (tid_ >> 6), nw = gridDim.x * 8;
    unsigned char* out8 = (unsigned char*)out;
    for (int row0 = gw; row0 < T; row0 += 2 * nw) {
        const int row1 = row0 + nw; const bool has1 = row1 < T; const int r1 = has1 ? row1 : row0;
        const float* xa = xin + (size_t)row0 * DM; const float* xb = xin + (size_t)r1 * DM; f32x4 va[8], vb[8]; float sa = 0.f, sb = 0.f;
#pragma unroll
        for (int j = 0; j < 4; ++j) {
            const int c8 = j * 512 + lane * 8;
            if (inb16) { const u32x4 wa_ = *(const u32x4*)((const bf16_t*)xin + (size_t)row0 * DM + c8), wb_ = *(const u32x4*)((const bf16_t*)xin + (size_t)r1 * DM + c8);
                va[2 * j] = f32x4{bflo(wa_.x), bfhi(wa_.x), bflo(wa_.y), bfhi(wa_.y)}; va[2 * j + 1] = f32x4{bflo(wa_.z), bfhi(wa_.z), bflo(wa_.w), bfhi(wa_.w)};
                vb[2 * j] = f32x4{bflo(wb_.x), bfhi(wb_.x), bflo(wb_.y), bfhi(wb_.y)}; vb[2 * j + 1] = f32x4{bflo(wb_.z), bfhi(wb_.z), bflo(wb_.w), bfhi(wb_.w)}; }
            else { va[2 * j] = *(const f32x4*)(xa + c8); va[2 * j + 1] = *(const f32x4*)(xa + c8 + 4); vb[2 * j] = *(const f32x4*)(xb + c8); vb[2 * j + 1] = *(const f32x4*)(xb + c8 + 4); } }
#pragma unroll
        for (int k = 0; k < 8; ++k) { sa += va[k][0] * va[k][0] + va[k][1] * va[k][1] + va[k][2] * va[k][2] + va[k][3] * va[k][3]; sb += vb[k][0] * vb[k][0] + vb[k][1] * vb[k][1] + vb[k][2] * vb[k][2] + vb[k][3] * vb[k][3]; }
        sa = wave_sum(sa); sb = wave_sum(sb); const float ra = rsqrtf(sa * (1.f / DM) + EPS), rb = rsqrtf(sb * (1.f / DM) + EPS);
        const float* ma = modl + (size_t)(row0 >> 13) * 6 * DM; const float* mb = modl + (size_t)(r1 >> 13) * 6 * DM;
#pragma unroll
        for (int j = 0; j < 4; ++j) { const int c8 = j * 512 + lane * 8;
#pragma unroll
            for (int rw = 0; rw < 2; ++rw) { if (rw == 1 && !has1) break;
                const float* mm = rw ? mb : ma; const float rr = rw ? rb : ra; const size_t ro = (size_t)(rw ? row1 : row0) * DM + c8;
                f32x4 y[2];
#pragma unroll
                for (int hh = 0; hh < 2; ++hh) { const int c = c8 + 4 * hh; const f32x4 g = *(const f32x4*)(gain + c), sc = *(const f32x4*)(mm + scale_off + c), sh = *(const f32x4*)(mm + shift_off + c);
                    y[hh] = (rw ? vb[2 * j + hh] : va[2 * j + hh]) * rr * g * (1.f + sc) + sh; }
                int p0 = __builtin_amdgcn_cvt_pk_fp8_f32(y[0][0], y[0][1], 0, false); p0 = __builtin_amdgcn_cvt_pk_fp8_f32(y[0][2], y[0][3], p0, true);
                int p1 = __builtin_amdgcn_cvt_pk_fp8_f32(y[1][0], y[1][1], 0, false); p1 = __builtin_amdgcn_cvt_pk_fp8_f32(y[1][2], y[1][3], p1, true);
                if (f8) *(u32x2*)(out8 + ro) = u32x2{(unsigned)p0, (unsigned)p1};
                else { *(u32x4*)(out + ro) = u32x4{cvt_pk_bf16(y[0][0], y[0][1]), cvt_pk_bf16(y[0][2], y[0][3]), cvt_pk_bf16(y[1][0], y[1][1]), cvt_pk_bf16(y[1][2], y[1][3])};
                       if (out8b) *(u32x2*)(out8b + ro) = u32x2{(unsigned)p0, (unsigned)p1}; } } }
    }
}

__device__ __forceinline__ void mla_cnorm_phase(const bf16_t* Z, const float* g_q, const float* g_kv, unsigned char* CQN, unsigned char* CKVN) {
    const int tid_ = otid(), lane = tid_ & 63, gw = obid() * 8 + (tid_ >> 6), nw = gridDim.x * 8;
    float gq[8], gk[8];
#pragma unroll
    for (int e = 0; e < 8; ++e) { gq[e] = g_q[lane * 8 + e]; gk[e] = g_kv[lane * 8 + e]; }
    for (int row = gw; row < T; row += nw) {
        const u32x4 a = *(const u32x4*)(Z + (size_t)row * MLA_IN_PAD + lane * 8), b = *(const u32x4*)(Z + (size_t)row * MLA_IN_PAD + 512 + lane * 8);
        float fa[8], fb[8]; unpack8(a, fa); unpack8(b, fb); float sa = 0.f, sb = 0.f;
#pragma unroll
        for (int e = 0; e < 8; ++e) { sa += fa[e] * fa[e]; sb += fb[e] * fb[e]; }
        sa = wave_sum(sa); sb = wave_sum(sb); const float ra = rsqrtf(sa * (1.f / 512) + EPS), rb = rsqrtf(sb * (1.f / 512) + EPS);
#pragma unroll
        for (int e = 0; e < 8; ++e) { fa[e] *= ra * gq[e]; fb[e] *= rb * gk[e]; }
        int a0 = __builtin_amdgcn_cvt_pk_fp8_f32(fa[0], fa[1], 0, false); a0 = __builtin_amdgcn_cvt_pk_fp8_f32(fa[2], fa[3], a0, true);
        int a1 = __builtin_amdgcn_cvt_pk_fp8_f32(fa[4], fa[5], 0, false); a1 = __builtin_amdgcn_cvt_pk_fp8_f32(fa[6], fa[7], a1, true);
        int b0 = __builtin_amdgcn_cvt_pk_fp8_f32(fb[0], fb[1], 0, false); b0 = __builtin_amdgcn_cvt_pk_fp8_f32(fb[2], fb[3], b0, true);
        int b1 = __builtin_amdgcn_cvt_pk_fp8_f32(fb[4], fb[5], 0, false); b1 = __builtin_amdgcn_cvt_pk_fp8_f32(fb[6], fb[7], b1, true);
        u32x2 wa = {(unsigned)a0, (unsigned)a1}, wb = {(unsigned)b0, (unsigned)b1};
        *(u32x2*)(CQN + (size_t)row * 512 + lane * 8) = wa; *(u32x2*)(CKVN + (size_t)row * 512 + lane * 8) = wb;
    }
}

__device__ __forceinline__ void mla_qkv_phase(const bf16_t* __restrict__ QRAW, const bf16_t* __restrict__ KVRAW, const bf16_t* __restrict__ Z, const int* __restrict__ pos, const float* __restrict__ g_qn, const float* __restrict__ g_kn,
                                              bf16_t* __restrict__ Q, bf16_t* __restrict__ K) {
    const int tid_ = otid(), lane = tid_ & 63, gw = obid() * 8 + (tid_ >> 6), nw = gridDim.x * 8;
    const int sub = lane & 31, hsel = lane >> 5;
    const bool isn = sub < 16, isr = sub >= 16 && sub < 24, act = sub < 24;
    const int e0 = isn ? sub * 8 : (128 + (sub - 16) * 8);
    float gq[8], gk[8];
#pragma unroll
    for (int e = 0; e < 8; ++e) { gq[e] = act ? g_qn[e0 + e] : 0.f; gk[e] = act ? g_kn[e0 + e] : 0.f; }
    const float QSC = 0.07216878364870322f * LOG2E;
    for (int row = gw; row < T; row += nw) {
        const int b = row >> 13, s = row & (SEQ - 1);
        float cs[8], sn[8];
        { const float p = (float)pos[row];
#pragma unroll
          for (int e = 0; e < 8; ++e) { const int fi = ((sub & 3) * 8 + e); const float inv = exp2f(-(float)fi * (13.287712379549449f / 32.f)); sincos_rev(p * inv, sn[e], cs[e]); } }
        u32x4 kr = {0u, 0u, 0u, 0u}; if (isr) kr = *(const u32x4*)(Z + (size_t)row * MLA_IN_PAD + 1024 + (sub - 16) * 8);
#pragma unroll 1
        for (int p4 = 0; p4 < 2; ++p4) {
            u32x4 wq[4], wk[4];
#pragma unroll
            for (int i = 0; i < 4; ++i) { const int h = (p4 * 4 + i) * 2 + hsel;
                wq[i] = (u32x4){0u, 0u, 0u, 0u}; if (act) wq[i] = *(const u32x4*)(QRAW + (size_t)row * 3072 + h * 192 + e0);
                wk[i] = kr; if (isn) wk[i] = *(const u32x4*)(KVRAW + (size_t)row * 4096 + h * 256 + sub * 8); }
#pragma unroll
            for (int i = 0; i < 4; ++i) { const int h = (p4 * 4 + i) * 2 + hsel;
#pragma unroll
                for (int qk = 0; qk < 2; ++qk) {
                    float f[8]; unpack8(qk == 0 ? wq[i] : wk[i], f); float ss = 0.f;
#pragma unroll
                    for (int e = 0; e < 8; ++e) ss += f[e] * f[e];
#pragma unroll
                    for (int o = 16; o >= 1; o >>= 1) ss += __shfl_xor(ss, o);
                    const float r = rsqrtf(ss * (1.f / 192) + EPS) * (qk == 0 ? QSC : 1.f);
#pragma unroll
                    for (int e = 0; e < 8; ++e) f[e] *= r * (qk == 0 ? gq[e] : gk[e]);
                    float y[8];
#pragma unroll
                    for (int e = 0; e < 8; ++e) { const float px = __shfl_xor(f[e], 4); y[e] = isr ? ((sub < 20) ? (f[e] * cs[e] - px * sn[e]) : (f[e] * cs[e] + px * sn[e])) : f[e]; }
                    if (act) { u32x4 o = {cvt_pk_bf16(y[0], y[1]), cvt_pk_bf16(y[2], y[3]), cvt_pk_bf16(y[4], y[5]), cvt_pk_bf16(y[6], y[7])};
                        *(u32x4*)((qk == 0 ? Q : K) + ((size_t)(b * MLA_H + h) * SEQ + s) * 192 + e0) = o; }
                }
            }
        }
    }
}

__device__ __forceinline__ void dil_combine_phase(const bf16_t* OG, const float* LSE, bf16_t* O) {
    const int tid_ = otid(), lane = tid_ & 63, gw = obid() * 8 + (tid_ >> 6), nw = gridDim.x * 8;
    for (int row = gw; row < T; row += nw) {
#pragma unroll
        for (int k = 0; k < 2; ++k) {
            const int col = k * 1024 + lane * 16, h = col >> 7;
            const float l0 = LSE[((size_t)0 * T + row) * 16 + h], l1 = LSE[((size_t)1 * T + row) * 16 + h], l2 = LSE[((size_t)2 * T + row) * 16 + h];
            const float mx = fmaxf(l0, fmaxf(l1, l2)); float w0 = exp2f(l0 - mx), w1 = exp2f(l1 - mx), w2 = exp2f(l2 - mx); const float inv = 1.f / (w0 + w1 + w2); w0 *= inv; w1 *= inv; w2 *= inv;
            unsigned q[4];
#pragma unroll
            for (int hh = 0; hh < 2; ++hh) { float a[8], b[8], c[8];
                unpack8(*(const u32x4*)(OG + ((size_t)0 * T + row) * DM + col + 8 * hh), a); unpack8(*(const u32x4*)(OG + ((size_t)1 * T + row) * DM + col + 8 * hh), b); unpack8(*(const u32x4*)(OG + ((size_t)2 * T + row) * DM + col + 8 * hh), c);
                float y[8];
#pragma unroll
                for (int e = 0; e < 8; ++e) y[e] = w0 * a[e] + w1 * b[e] + w2 * c[e];
                int q0 = __builtin_amdgcn_cvt_pk_fp8_f32(y[0] * ACT_F8SCALE, y[1] * ACT_F8SCALE, 0, false); q0 = __builtin_amdgcn_cvt_pk_fp8_f32(y[2] * ACT_F8SCALE, y[3] * ACT_F8SCALE, q0, true);
                int q1 = __builtin_amdgcn_cvt_pk_fp8_f32(y[4] * ACT_F8SCALE, y[5] * ACT_F8SCALE, 0, false); q1 = __builtin_amdgcn_cvt_pk_fp8_f32(y[6] * ACT_F8SCALE, y[7] * ACT_F8SCALE, q1, true);
                q[2 * hh] = (unsigned)q0; q[2 * hh + 1] = (unsigned)q1; }
            *(u32x4*)((unsigned char*)O + (size_t)row * DM + col) = u32x4{q[0], q[1], q[2], q[3]};
        }
    }
}

namespace rt {
__device__ __forceinline__ int f2key(float s) { const int u = (int)__float_as_uint(s); return u ^ (int)((unsigned)(u >> 31) >> 1); }
__device__ __forceinline__ float key2f(int k) { return __uint_as_float((unsigned)(k ^ (int)((unsigned)(k >> 31) >> 1))); }
template <int N> __device__ __forceinline__ void sort_desc(int (&v)[N]) {
#pragma unroll
    for (int k = 2; k <= N; k <<= 1) {
#pragma unroll
        for (int j = k >> 1; j > 0; j >>= 1) {
#pragma unroll
            for (int i = 0; i < N; ++i) { const int l = i ^ j;
                if (l > i) { const bool desc = ((i & k) == 0); const int a = v[i], b = v[l]; const int mx = a > b ? a : b, mn = a > b ? b : a; v[i] = desc ? mx : mn; v[l] = desc ? mn : mx; } }
        }
    }
}
__device__ __forceinline__ void bitonic_merge_desc16(int (&v)[16]) {
#pragma unroll
    for (int j = 8; j > 0; j >>= 1) {
#pragma unroll
        for (int i = 0; i < 16; ++i) { const int l = i ^ j; if (l > i) { const int a = v[i], b = v[l]; v[i] = a > b ? a : b; v[l] = a > b ? b : a; } }
    }
}
__device__ __forceinline__ void merge_top16(int (&a)[16], const int (&b)[16]) {
#pragma unroll
    for (int i = 0; i < 16; ++i) { const int x = a[i], y = b[15 - i]; a[i] = x > y ? x : y; }
    bitonic_merge_desc16(a);
}
__device__ __forceinline__ void merge_partner(int (&a)[16], int hi) {
    int b[16];
#pragma unroll
    for (int i = 0; i < 16; ++i) { auto rr = __builtin_amdgcn_permlane32_swap((unsigned)a[i], (unsigned)a[i], false, false); b[i] = (int)(hi ? rr[0] : rr[1]); }
    merge_top16(a, b);
}
#define RT_CAND_LIST(X) X(0,0,0) X(1,0,1) X(2,0,2) X(3,0,3) X(4,0,4) X(5,0,5) X(6,0,6) X(7,0,7) X(8,0,8) X(9,0,9) X(10,0,10) X(11,0,11) X(12,0,12) X(13,0,13) X(14,0,14) X(15,0,15) X(16,1,0) X(17,1,1) X(18,1,2) X(19,1,3) X(20,1,4) X(21,1,5) X(22,1,6) X(23,1,7) X(24,2,0) X(25,2,1) X(26,2,2) X(27,2,3) X(28,2,4) X(29,3,0) X(30,3,1) X(31,3,2) X(32,3,3) X(33,4,0) X(34,4,1) X(35,4,2) X(36,5,0) X(37,5,1) X(38,6,0) X(39,6,1) X(40,7,0) X(41,7,1) X(42,8,0) X(43,9,0) X(44,10,0) X(45,11,0) X(46,12,0) X(47,13,0) X(48,14,0) X(49,15,0)

__device__ __forceinline__ void route_item(const bf16_t* PQ, const bf16_t* SUBK  , int t0, int h, int* IDX, float* GATE, LAS int* lds_w) {
    const int lane = otid() & 63, r32 = lane & 31, hi = lane >> 5;
    int top[2][16];
#pragma unroll
    for (int p = 0; p < 2; ++p) {
        bf16x8 bq[8];
        { const bf16_t* qp = PQ + ((size_t)(((t0 >> 5) * 8 + h) * 2 + p) << 12) + (size_t)lane * 8;
          asm volatile("" : "+v"(qp));
#pragma unroll
          for (int ks = 0; ks < 8; ++ks) bq[ks] = *reinterpret_cast<const bf16x8*>(qp + ks * 512); }
        int cur[16];
#pragma unroll
        for (int kb = 0; kb < 4; ++kb) { f32x16 acc = f32x16{};
            const bf16_t* kp = SUBK + (size_t)(h * 2 + p) * 16384 + (size_t)(kb * 8 * 64 + lane) * 8;
            asm volatile("" : "+v"(kp));
            bf16x8 af[8];
#pragma unroll
            for (int ks = 0; ks < 8; ++ks) af[ks] = *reinterpret_cast<const bf16x8*>(kp + ks * 512);
#pragma unroll
            for (int ks = 0; ks < 8; ++ks) acc = __builtin_amdgcn_mfma_f32_32x32x16_bf16(af[ks], bq[ks], acc, 0, 0, 0);
            int v[16];
#pragma unroll
            for (int r = 0; r < 16; ++r) { const int key = kb * 32 + (r & 3) + 8 * (r >> 2) + 4 * hi; v[r] = (f2key(acc[r]) & ~0x7F) | key; }
            sort_desc<16>(v);
            if (kb == 0) {
#pragma unroll
                for (int r = 0; r < 16; ++r) cur[r] = v[r]; }
            else merge_top16(cur, v);
            __builtin_amdgcn_sched_barrier(0); }
        merge_partner(cur, hi);
#pragma unroll
        for (int r = 0; r < 16; ++r) top[p][r] = cur[r];
    }
    float sa[16], sb[16];
#pragma unroll
    for (int r = 0; r < 16; ++r) { sa[r] = key2f(top[0][r] & ~0x7F); sb[r] = key2f(top[1][r] & ~0x7F); }
    int best[16];
    { int cv[64];
#pragma unroll
      for (int n = 50; n < 64; ++n) cv[n] = (int)0x80000000;
#define RT_CX(n, i, j) cv[n] = (f2key(sa[i] + sb[j]) & ~0xFF) | ((i) * 16 + (j));
      RT_CAND_LIST(RT_CX)
#undef RT_CX
#pragma unroll
      for (int gI = 0; gI < 4; ++gI) { int v[16];
#pragma unroll
          for (int r = 0; r < 16; ++r) v[r] = cv[gI * 16 + r];
          sort_desc<16>(v);
          if (gI == 0) {
#pragma unroll
              for (int r = 0; r < 16; ++r) best[r] = v[r]; }
          else merge_top16(best, v); } }
#pragma unroll
    for (int r = 0; r < 16; ++r) { lds_w[r * 64 + lane] = top[0][r]; lds_w[(16 + r) * 64 + lane] = top[1][r]; }
    asm volatile("s_waitcnt lgkmcnt(0)" ::: "memory");
    int eidx[16]; float sc[16]; float mx = -1e30f;
#pragma unroll
    for (int k = 0; k < 16; ++k) { const int code = best[k] & 0xFF; const int a = lds_w[(code >> 4) * 64 + lane], b = lds_w[(16 + (code & 15)) * 64 + lane];
        eidx[k] = (a & 0x7F) * 128 + (b & 0x7F); sc[k] = key2f(a & ~0x7F) + key2f(b & ~0x7F); mx = fmaxf(mx, sc[k]); }
    float sum = 0.f;
#pragma unroll
    for (int k = 0; k < 16; ++k) { sc[k] = __expf(sc[k] - mx); sum += sc[k]; }
    const float inv = 1.f / sum;
    asm volatile("s_waitcnt lgkmcnt(0)" ::: "memory");
    const size_t off = (size_t)(t0 + r32) * 128 + h * 16;
    unsigned* dst = hi ? (unsigned*)(GATE + off) : (unsigned*)(IDX + off);
#pragma unroll
    for (int q = 0; q < 4; ++q) { u32x4 w;
        w.x = hi ? __float_as_uint(sc[q * 4 + 0] * inv) : (unsigned)eidx[q * 4 + 0]; w.y = hi ? __float_as_uint(sc[q * 4 + 1] * inv) : (unsigned)eidx[q * 4 + 1];
        w.z = hi ? __float_as_uint(sc[q * 4 + 2] * inv) : (unsigned)eidx[q * 4 + 2]; w.w = hi ? __float_as_uint(sc[q * 4 + 3] * inv) : (unsigned)eidx[q * 4 + 3];
        *(u32x4*)(dst + q * 4) = w; }
}
}
__device__ __forceinline__ void route_phase(const bf16_t* PQ, const bf16_t* SUBK, int* IDX, float* GATE, LAS unsigned char* lds) {
    const int wid = otid() >> 6, gw = obid() * 8 + wid, nw = gridDim.x * 8;
    LAS int* lw = (LAS int*)(lds + wid * 8192);
    for (int it = gw; it < (T / 32) * PEER_H; it += nw) { const int tt = it >> 3, h = it & 7; rt::route_item(PQ, SUBK, tt * 32, h, IDX, GATE, lw); }
}

__device__ __forceinline__ float gelu_erf(float x) { return 0.5f * x * (1.f + erff(x * 0.70710678118654752f)); }
#define PE_POS(j) ((((j) & 7) << 4) | ((j) >> 3))
constexpr int PE_OFFP = 132, PE_ACTP = 132;
constexpr int PE_VB_PITCH = 136, PE_VB_BYTES = 64 * PE_VB_PITCH;
static_assert(64 * 132 * 4 + 2 * 64 * 128 + 256 + 8 * PE_VB_BYTES + 8 * 1024 <= 128 * 1024, "expert phase LDS");
constexpr int PE_OFF_BYTES = 64 * PE_OFFP * 4, PE_ACT_BYTES = 64 * PE_ACTP * 4;
__device__ __forceinline__ float dot_fp8x4(unsigned w, unsigned xa, unsigned xb, float s) {
    const bf16x2_t q0 = __builtin_amdgcn_cvt_scalef32_pk_bf16_fp8(w, 1.0f, false), q1 = __builtin_amdgcn_cvt_scalef32_pk_bf16_fp8(w, 1.0f, true);
    s = __builtin_amdgcn_fdot2_f32_bf16(q0, __builtin_bit_cast(bf16x2_t, xa), s, false); return __builtin_amdgcn_fdot2_f32_bf16(q1, __builtin_bit_cast(bf16x2_t, xb), s, false);
}
__device__ __forceinline__ void peer_phase(const unsigned char* H8, const int* IDX, const float* GATE, const unsigned char* U, const unsigned char* V, const float* usc, const float* vsc,
                                           const float* xin  , const float* gate2, float* out, int out_b16  , LAS unsigned char* lds) {
    const int tid = otid(), lane = tid & 63, wid = tid >> 6, g = lane >> 3, l8 = lane & 7, tw = wid * 8 + g;
    LAS unsigned* offl = (LAS unsigned*)lds; LAS unsigned char* a8hi = lds + PE_OFF_BYTES; LAS unsigned char* a8lo = a8hi + 64 * 128; LAS float* tscl = (LAS float*)(a8lo + 64 * 128);
    LAS unsigned char* vbw = lds + PE_OFF_BYTES + 2 * 64 * 128 + 256 + wid * PE_VB_BYTES; LAS float* actw = (LAS float*)vbw;
    const LAS u32x4* offrow = (const LAS u32x4*)(offl + tw * PE_OFFP);
    const unsigned lpart = (unsigned)l8 * 16u;
    for (int tile = obid(); tile < T / 64; tile += gridDim.x) {
        const int t0 = tile * 64, t = t0 + tw, b = t >> 13;
        __syncthreads();
        { int iv[16];
#pragma unroll
          for (int q = 0; q < 16; ++q) iv[q] = IDX[(size_t)t0 * 128 + tid + 512 * q];
          const int tp_ = otid();
#pragma unroll
          for (int q = 0; q < 16; ++q) { const int i = tp_ + 512 * q; offl[(i >> 7) * PE_OFFP + PE_POS(i & 127)] = ((unsigned)iv[q]) << 7; } }
        __syncthreads();
        {
            const int lane = otid() & 63;
            const int m16 = lane & 15, kg = lane >> 4;
            const unsigned lpu = (unsigned)((lane & 7) * 16);
            const int bidx = 4 * (8 * (m16 >> 1) + (m16 & 1) + 2 * kg);
            f32x4 acc[8][2];
#pragma unroll
            for (int a_ = 0; a_ < 8; ++a_) { acc[a_][0] = f32x4{0.f, 0.f, 0.f, 0.f}; acc[a_][1] = f32x4{0.f, 0.f, 0.f, 0.f}; }
            const unsigned char* hrow = H8 + (size_t)(t0 + wid * 8) * DM + 64 * (kg >> 1) + 16 * (kg & 1) + 32 * (m16 & 1);
            const LAS u32x4* offw = (const LAS u32x4*)(offl + (wid * 8) * PE_OFFP + (lane >> 3) * 16);
            const int mq = m16 >> 1;
            u32x4 buf[16]; u32x4 hA, hB;
            { const LAS u32x4* offc = offw; asm volatile("" : "+v"(offc));
              const u32x4 o0 = offc[0], o1 = offc[1], o2 = offc[2], o3 = offc[3];
              hA = *(const u32x4*)(hrow); hB = *(const u32x4*)(hrow + 128);
              __builtin_amdgcn_sched_barrier(0);
#define PE_UL(g, ov) buf[g] = *(const u32x4*)((const char*)U + (size_t)((ov) + lpu));
              PE_UL(0, o0.x) PE_UL(8, o2.x) PE_UL(1, o0.y) PE_UL(9, o2.y) PE_UL(2, o0.z) PE_UL(10, o2.z) PE_UL(3, o0.w) PE_UL(11, o2.w)
              PE_UL(4, o1.x) PE_UL(12, o3.x) PE_UL(5, o1.y) PE_UL(13, o3.y) PE_UL(6, o1.z) PE_UL(14, o3.z) PE_UL(7, o1.w) PE_UL(15, o3.w)
#undef PE_UL
              __builtin_amdgcn_sched_barrier(0); }
#define PE_PERM(dst, src) { const u32x4 s_ = (src); (dst).x = (unsigned)__builtin_amdgcn_ds_bpermute(bidx, (int)s_.x); (dst).y = (unsigned)__builtin_amdgcn_ds_bpermute(bidx, (int)s_.y); (dst).z = (unsigned)__builtin_amdgcn_ds_bpermute(bidx, (int)s_.z); (dst).w = (unsigned)__builtin_amdgcn_ds_bpermute(bidx, (int)s_.w); }
            u32x4 tq[4]; PE_PERM(tq[0], buf[0]) PE_PERM(tq[1], buf[8])
#pragma unroll 1
            for (int c = 0; c < 8; ++c) {
                const char* ub = (const char*)(U + (size_t)c * PEER_E * 128);
                const int cn = c + 1 < 8 ? c + 1 : c;
                const char* ubn = (const char*)(U + (size_t)cn * PEER_E * 128);
#pragma unroll
                for (int tk = 0; tk < 8; ++tk) {
                    const int tkn = (tk + 1) & 7; const char* nb_ = tk == 7 ? ubn : ub; const int ccn = tk == 7 ? cn : c;
                    const LAS u32x4* offc = offw + tkn * (PE_OFFP / 4); asm volatile("" : "+v"(offc));
                    const u32x4 o0 = offc[0], o1 = offc[1], o2 = offc[2], o3 = offc[3];
                    const unsigned char* hn = hrow + (size_t)tkn * DM + ccn * 256;
                    const u32x4 hnA = *(const u32x4*)(hn), hnB = *(const u32x4*)(hn + 128);
                    __builtin_amdgcn_sched_barrier(0);
#define PE_UM(q, sft, ovA, ovB) { const bool sel = mq == (q); pg8::i32x8 hv; \
                        hv[0] = sel ? (int)hA.x : 0; hv[1] = sel ? (int)hA.y : 0; hv[2] = sel ? (int)hA.z : 0; hv[3] = sel ? (int)hA.w : 0; hv[4] = sel ? (int)hB.x : 0; hv[5] = sel ? (int)hB.y : 0; hv[6] = sel ? (int)hB.z : 0; hv[7] = sel ? (int)hB.w : 0; \
                        { PE_PERM(tq[(2 * (q) + 2) & 3], buf[((q) + 1) & 7]) const u32x4 t_ = tq[(2 * (q)) & 3]; const pg8::i32x8 rv = {(int)t_.x, (int)t_.y, (int)t_.z, (int)t_.w, 0, 0, 0, 0}; \
                          acc[tk][0] = __builtin_amdgcn_mfma_scale_f32_16x16x128_f8f6f4(hv, rv, acc[tk][0], 0, 4, 0, 0x7F7F7F7F, 0, 0x7F7F7F7F); buf[q] = *(const u32x4*)(nb_ + (size_t)((ovA) + lpu)); } \
                        __builtin_amdgcn_sched_barrier(0); \
                        { PE_PERM(tq[(2 * (q) + 3) & 3], buf[8 + (((q) + 1) & 7)]) const u32x4 t_ = tq[(2 * (q) + 1) & 3]; const pg8::i32x8 rv = {(int)t_.x, (int)t_.y, (int)t_.z, (int)t_.w, 0, 0, 0, 0}; \
                          acc[tk][1] = __builtin_amdgcn_mfma_scale_f32_16x16x128_f8f6f4(hv, rv, acc[tk][1], 0, 4, 0, 0x7F7F7F7F, 0, 0x7F7F7F7F); buf[8 + (q)] = *(const u32x4*)(nb_ + (size_t)((ovB) + lpu)); } \
                        __builtin_amdgcn_sched_barrier(0); }
                    PE_UM(0, 0, o0.x, o2.x) PE_UM(1, 0, o0.y, o2.y) PE_UM(2, 0, o0.z, o2.z) PE_UM(3, 0, o0.w, o2.w) PE_UM(4, 0, o1.x, o3.x) PE_UM(5, 0, o1.y, o3.y) PE_UM(6, 0, o1.z, o3.z) PE_UM(7, 0, o1.w, o3.w)
#undef PE_UM
                    hA = hnA; hB = hnB;
                }
            }
#undef PE_PERM
#pragma unroll
            for (int tk = 0; tk < 8; ++tk)
#pragma unroll
                for (int hs = 0; hs < 2; ++hs) { const f32x4 a_ = acc[tk][hs];
                    const float v0 = a_[0] + __shfl_xor(a_[1], 1), v1 = a_[2] + __shfl_xor(a_[3], 1);
                    if ((m16 & 1) == 0) { LAS float* ap = actw + tk * PE_ACTP + (m16 >> 1) * 16 + hs * 8 + 2 * kg; ap[0] = v0; ap[1] = v1; } }
        }
        {
            const int lane = otid() & 63;
            float gt[8][2], su[8][2], sv[8][2];
#pragma unroll
            for (int tk = 0; tk < 8; ++tk)
#pragma unroll
                for (int hf = 0; hf < 2; ++hf) { const int j = lane + 64 * hf; const unsigned ex = offl[(wid * 8 + tk) * PE_OFFP + PE_POS(j)] >> 7;
                    gt[tk][hf] = GATE[(size_t)(t0 + wid * 8 + tk) * 128 + j]; { typedef float f32x2_t __attribute__((ext_vector_type(2))); const f32x2_t s2_ = *(const f32x2_t*)(usc + 2 * (size_t)ex); su[tk][hf] = s2_[0]; sv[tk][hf] = s2_[1]; } }
            const int kr = (lane & 0x30) == 0x10 ? lane + 16 : ((lane & 0x30) == 0x20 ? lane - 16 : lane);
#pragma unroll
            for (int tk = 0; tk < 8; ++tk) { float av[2]; float mx = 0.f;
#pragma unroll
                for (int hf = 0; hf < 2; ++hf) { const int j = lane + 64 * hf; av[hf] = gelu_erf(actw[tk * PE_ACTP + PE_POS(j)] * su[tk][hf]) * gt[tk][hf] * sv[tk][hf]; mx = fmaxf(mx, fabsf(av[hf])); }
#pragma unroll
                for (int o = 32; o >= 1; o >>= 1) mx = fmaxf(mx, __shfl_xor(mx, o));
                const int exm = (int)((__float_as_uint(mx) >> 23) & 0xff);
                int se = 261 - exm; se = se < 1 ? 1 : (se > 254 ? 254 : se);
                const float sc_ = exm == 0 ? 1.f : __uint_as_float((unsigned)se << 23);
                if (lane == 0) tscl[wid * 8 + tk] = 1.f / sc_;
#pragma unroll
                for (int hf = 0; hf < 2; ++hf) { const float x_ = av[hf] * sc_;
                    const int ph = __builtin_amdgcn_cvt_pk_fp8_f32(x_, 0.f, 0, false); const float hif = __builtin_amdgcn_cvt_f32_fp8(ph, 0);
                    const int pl = __builtin_amdgcn_cvt_pk_fp8_f32(x_ - hif, 0.f, 0, false);
                    a8hi[(wid * 8 + tk) * 128 + hf * 64 + kr] = (unsigned char)(ph & 0xff); a8lo[(wid * 8 + tk) * 128 + hf * 64 + kr] = (unsigned char)(pl & 0xff); } }
        }
        {
            const int lane = otid() & 63;
            const int q16 = lane & 15, kg = lane >> 4, kgm = kg & 1, r8 = lane >> 3, p8 = lane & 7;
            const LAS unsigned char* tr1 = vbw + (16 * kgm + q16) * PE_VB_PITCH + 32 * (kg >> 1); const LAS unsigned char* tr2 = tr1 + 32 * PE_VB_PITCH;
            LAS unsigned char* wr = vbw + r8 * PE_VB_PITCH + p8 * 16;
            const LAS u32x4* offw = (const LAS u32x4*)(offl + (wid * 8) * PE_OFFP + r8 * 16);
            const unsigned lpv = (unsigned)(p8 * 16);
            const int vsel = q16 >> 2, vhl = q16 & 3;
            const LAS unsigned char* a8p = ((vhl & 1) == 0 ? a8hi : a8lo) + (wid * 8) * 128 + 16 * kg;
            typedef int i32x2_t __attribute__((ext_vector_type(2)));
            LAS float* ystg = (LAS float*)(lds + PE_OFF_BYTES + 2 * 64 * 128 + 256 + 8 * PE_VB_BYTES + wid * 1024);
            u32x4 buf[16];
            { const LAS u32x4* offc = offw; asm volatile("" : "+v"(offc)); const u32x4 o0 = offc[0], o1 = offc[1], o2 = offc[2], o3 = offc[3];
#define PE_VL(g, ov, base_) buf[g] = *(const u32x4*)((base_) + (size_t)((ov) + lpv));
              PE_VL(0, o0.x, (const char*)V) PE_VL(1, o0.y, (const char*)V) PE_VL(2, o0.z, (const char*)V) PE_VL(3, o0.w, (const char*)V) PE_VL(4, o1.x, (const char*)V) PE_VL(5, o1.y, (const char*)V) PE_VL(6, o1.z, (const char*)V) PE_VL(7, o1.w, (const char*)V)
              PE_VL(8, o2.x, (const char*)V) PE_VL(9, o2.y, (const char*)V) PE_VL(10, o2.z, (const char*)V) PE_VL(11, o2.w, (const char*)V) PE_VL(12, o3.x, (const char*)V) PE_VL(13, o3.y, (const char*)V) PE_VL(14, o3.z, (const char*)V) PE_VL(15, o3.w, (const char*)V)
              __builtin_amdgcn_sched_barrier(0); }
#pragma unroll 1
            for (int c = 0; c < 8; ++c) {
                const char* vb_ = (const char*)(V + (size_t)c * PEER_E * 128);
                const int cn = c + 1 < 8 ? c + 1 : c;
                const char* vbn = (const char*)(V + (size_t)cn * PEER_E * 128);
                const f32x4 gr = *(const f32x4*)(gate2 + (size_t)(t0 >> 13) * 6 * DM + c * 256 + 4 * lane);
#pragma unroll 1
                for (int tk = 0; tk < 8; ++tk) {
                    const int tkn = (tk + 1) & 7; const char* nb_ = tk == 7 ? vbn : vb_;
                    const LAS u32x4* offc = offw + tkn * (PE_OFFP / 4); asm volatile("" : "+v"(offc));
                    const int tt = t0 + wid * 8 + tk; const int colb = c * 256 + 16 * kg + q16;
                    const u32x2 xw = *(const u32x2*)((const bf16_t*)xin + (size_t)tt * DM + c * 256 + 4 * lane);
                    const float tsc = tscl[wid * 8 + tk];
                    f32x4 acc[2];
#pragma unroll
                    for (int bq = 0; bq < 2; ++bq) acc[bq] = f32x4{0.f, 0.f, 0.f, 0.f};
#pragma unroll
                    for (int hu = 0; hu < 2; ++hu) {
                        const u32x4 on0 = offc[2 * hu], on1 = offc[2 * hu + 1];
#pragma unroll
                        for (int g8 = 0; g8 < 8; ++g8) { const u32x4 d_ = buf[hu * 8 + g8]; *(LAS u32x2*)(wr + g8 * 8 * PE_VB_PITCH) = u32x2{d_.x, d_.y}; *(LAS u32x2*)(wr + g8 * 8 * PE_VB_PITCH + 8) = u32x2{d_.z, d_.w}; }
                        { const unsigned ov[8] = {on0.x, on0.y, on0.z, on0.w, on1.x, on1.y, on1.z, on1.w};
#pragma unroll
                          for (int g8 = 0; g8 < 8; ++g8) buf[hu * 8 + g8] = *(const u32x4*)(nb_ + (size_t)(ov[g8] + lpv)); }
                        const u32x4 araw = *(const LAS u32x4*)(a8p + tk * 128 + hu * 64);
                        __builtin_amdgcn_sched_barrier(0);
                        i32x2_t ta[4], tb[4];
#define PE_TR(st) { const int nb_k = 8 * ((st) & 1) + ((st) >> 1); ta[(st) & 3] = __builtin_amdgcn_ds_read_tr4_b64_v2i32((LAS i32x2_t*)(tr1 + 8 * nb_k)); tb[(st) & 3] = __builtin_amdgcn_ds_read_tr4_b64_v2i32((LAS i32x2_t*)(tr2 + 8 * nb_k)); }
                        PE_TR(0) PE_TR(1) PE_TR(2)
#pragma unroll
                        for (int st = 0; st < 8; ++st) { const int vr = st >> 1, bq = st & 1; const bool s0 = (vsel == vr) && (vhl < 2), s1 = (vsel == vr) && (vhl >= 2);
                            const pg8::i32x8 hv = {s0 ? (int)araw.x : 0, s0 ? (int)araw.y : 0, s0 ? (int)araw.z : 0, s0 ? (int)araw.w : 0, s1 ? (int)araw.x : 0, s1 ? (int)araw.y : 0, s1 ? (int)araw.z : 0, s1 ? (int)araw.w : 0};
                            if (st + 3 < 8) PE_TR(st + 3)
                            const pg8::i32x8 rv = {ta[st & 3].x, ta[st & 3].y, tb[st & 3].x, tb[st & 3].y, 0, 0, 0, 0};
                            acc[bq] = __builtin_amdgcn_mfma_scale_f32_16x16x128_f8f6f4(hv, rv, acc[bq], 0, 4, 0, 0x7F7F7F7F, 0, 0x7F7F7F7F);
                            __builtin_amdgcn_sched_barrier(0); }
#undef PE_TR
                        __builtin_amdgcn_sched_barrier(0);
                    }
#pragma unroll
                    for (int bq = 0; bq < 2; ++bq)
#pragma unroll
                        for (int sb = 0; sb < 2; ++sb) ystg[128 * bq + 64 * sb + 16 * kg + q16] = (acc[bq][2 * sb] + acc[bq][2 * sb + 1]) * tsc;
                    { const f32x4 yv = *(const LAS f32x4*)(ystg + 4 * lane); const f32x4 xr = {bflo(xw.x), bfhi(xw.x), bflo(xw.y), bfhi(xw.y)}; const f32x4 o_ = xr + gr * yv; const size_t oi = (size_t)tt * DM + c * 256 + 4 * lane;
                      if (out_b16) *(u32x2*)((bf16_t*)out + oi) = u32x2{cvt_pk_bf16(o_[0], o_[1]), cvt_pk_bf16(o_[2], o_[3])}; else *(f32x4*)(out + oi) = o_; }
                }
            }
#undef PE_VL
        }
#undef PE_ISSUE
    }
}

constexpr int NPL = 13, NPH = 1 + DEPTH * NPL;
__host__ __device__ constexpr bool phase_exists(int ph) { if (ph == 0) return true; const int k = (ph - 1) % NPL, layer = (ph - 1) / NPL; return ((layer & 1) == 0) ? !(k == 6 || k == 7) : !(k == 2 || k == 5); }
__global__ void __launch_bounds__(512, 2) fwd_kernel(Args A) {
    extern __shared__ __attribute__((aligned(16))) unsigned char lds_raw[];
    LAS unsigned char* lds = (LAS unsigned char*)lds_raw;
    unsigned char* ws_ = A.ws;
#define WSB ow(ws_)
    const int G = gridDim.x, bid = blockIdx.x;
    volatile LAS unsigned* misc = (volatile LAS unsigned*)(lds + LDS_MAIN);
    if (threadIdx.x < 4) misc[threadIdx.x] = 0u;
    __syncthreads();
    XcdBarrier bar; bar.bar = (unsigned*)(WSB + WS_CTL); bar.x = 0; bar.st = misc;
    const bool fused = (A.ph_hi - A.ph_lo) > 1;
    if (fused) bar = xcd_barrier_post((unsigned*)(WSB + WS_CTL), misc);
    const float* MOD = (const float*)(WSB + WS_CTL + CTL_MOD_OFF);
#define HB ((bf16_t*)(WSB + WS_HB))
#define XA ((float*)(WSB + WS_XA))
#define XB ((float*)(WSB + WS_XB))
    bf16_t* OB = (bf16_t*)A.out;
#define PQ ((bf16_t*)(WSB + WS_PQ))
#define IDX ((int*)(WSB + WS_IDX))
#define GATE ((float*)(WSB + WS_GATE))
#define R1 (WSB + WS_R1)
#define IN(k) (A.ph_lo <= (k) && (k) < A.ph_hi)
#define SEAM(k) do { if ((k) + 1 < A.ph_hi) xcd_barrier(bar); } while (0)
#define REPS(bit) for (int rp_ = 0; rp_ < ((((REP_MASK) >> (bit)) & 1) ? 2 : 1); ++rp_)
#define REPB(bit) do { if ((((REP_MASK) >> (bit)) & 1) && fused) xcd_barrier(bar); } while (0)
    if (IN(0)) { REPS(0) { prologue_phase(A, lds); REPB(0); } SEAM(0); }
#pragma unroll 1
    for (int layer = 0; layer < DEPTH; ++layer) {
        const int pb = 1 + layer * NPL;
        const float* modl = MOD + (size_t)layer * 2 * 6 * DM;
        const float* xcur = layer == 0 ? A.x : XB;
        float* xout = layer == DEPTH - 1 ? A.out : XB;
        const bool mla = (layer & 1) == 0;
        if (IN(pb + 0)) { REPS(1) { norm_phase(xcur, A.norm_g + (size_t)(layer * 2 + 0) * DM, modl, 0, DM, HB, 1, nullptr, layer > 0); REPB(1); } SEAM(pb + 0); }
        const int nsub = mla ? 1 : 2;
#pragma unroll 1
        for (int sb = 0; sb < nsub; ++sb) {
            if (IN(pb + 1 + 3 * sb)) {
                pg8::Gemm g; pg8::EpiBf16 E;
                if (mla) { g = pg8::Gemm{HB, (const bf16_t*)(WSB + WS_WIN_MLA), T, MLA_IN_PAD, DM / 2}; E = pg8::EpiBf16{(bf16_t*)(R1 + R1_Z), MLA_IN_PAD, 0, nullptr, nullptr, nullptr, nullptr, nullptr, 1.f / DIL_WSCALE, nullptr}; }
                else { const unsigned* csT = (const unsigned*)(WSB + WS_ROPE) + (size_t)sb * SEQ * 64;
                       g = pg8::Gemm{(const bf16_t*)((const unsigned char*)HB + (size_t)sb * SEQ * DM), (const bf16_t*)(WSB + WS_WIN_DIL), SEQ, DIL_IN, DM / 2};
                       E = pg8::EpiBf16{(bf16_t*)(R1 + R1_ZD), DIL_IN, 1, csT, nullptr, A.dil_g_qn, A.dil_g_kn, (LAS float*)(lds + LDS_XCH), 1.f / DIL_WSCALE, nullptr}; }
                pg8::StaticOrder S; S.init(g.M, g.N, G, bid);
                REPS(2) { pg8::gemm_phase<pg8::EpiBf16, pg8::StaticOrder, true>(lds, g, S, E); REPB(2); }
                SEAM(pb + 1 + 3 * sb);
            }
            if (mla && IN(pb + 2)) {
                REPS(3) { mla_cnorm_phase((const bf16_t*)(R1 + R1_Z), A.mla_g_q, A.mla_g_kv, R1 + R1_CQN, R1 + R1_CKVN); REPB(3); }
                SEAM(pb + 2);
            }
            if (mla) {
                if (IN(pb + 3)) {
                    REPS(4) {
#pragma unroll 1
                    for (int w = 0; w < 2; ++w) {
                        pg8::Gemm g = w == 0 ? pg8::Gemm{(const bf16_t*)(R1 + R1_CQN), (const bf16_t*)(WSB + WS_WUQ), T, 3072, 256} : pg8::Gemm{(const bf16_t*)(R1 + R1_CKVN), (const bf16_t*)(WSB + WS_WUKV), T, 4096, 256};
                        pg8::EpiBf16 E = w == 0 ? pg8::EpiBf16{(bf16_t*)(WSB + WS_QRAW), 3072, 0, nullptr, nullptr, nullptr, nullptr, nullptr, 1.f / DIL_WSCALE, nullptr} : pg8::EpiBf16{(bf16_t*)(WSB + WS_KVRAW), 4096, 0, nullptr, nullptr, nullptr, nullptr, nullptr, 1.f / DIL_WSCALE, (bf16_t*)(R1 + R1_V)};
                        pg8::StaticOrder S; S.init(g.M, g.N, G, bid);
                        pg8::gemm_phase<pg8::EpiBf16, pg8::StaticOrder, true>(lds, g, S, E);
                    }
                    REPB(4); }
                    SEAM(pb + 3);
                }
                if (IN(pb + 4)) {
                    REPS(5) { mla_qkv_phase((const bf16_t*)(WSB + WS_QRAW), (const bf16_t*)(WSB + WS_KVRAW), (const bf16_t*)(R1 + R1_Z), A.pos, A.mla_g_qn, A.mla_g_kn, (bf16_t*)(R1 + R1_Q), (bf16_t*)(R1 + R1_K)); REPB(5); }
                    SEAM(pb + 4);
                }
                if (IN(pb + 5)) {
                    const bf16_t* Qb = (const bf16_t*)(R1 + R1_Q); const bf16_t* Kb = (const bf16_t*)(R1 + R1_K); const bf16_t* Vb = (const bf16_t*)(R1 + R1_V);
                    REPS(6) {
                    for (int x = bid; x < 512; x += G) {
                        const int xl = x & 255, xcd = xl & 7, idx = xl >> 3; const int bh = (x >> 8) * 16 + xcd * 2 + (idx >> 4), y = idx & 15, b = bh >> 4, h = bh & 15;
#pragma unroll 1
                        for (int pass = 0; pass < 2; ++pass) {
                            const int qb = pass == 0 ? 31 - y : y;
                            at::Item it; it.Q = Qb + (size_t)bh * SEQ * 192; it.K = Kb + (size_t)bh * SEQ * 192; it.V = Vb + (size_t)bh * SEQ * 128;
                            it.O = (bf16_t*)((unsigned char*)OB + (size_t)b * SEQ * DM + h * 128); it.o_f8 = 1; it.LSE = nullptr; it.qs = 192; it.ks = 192; it.vs = 128; it.os = DM; it.ls = 0; it.i0 = qb * 256; it.W = 1 << 30; it.L = SEQ;
                            at::attn_block<192>(it, (LAS char*)lds);
                        }
                    }
                    REPB(6); }
                    SEAM(pb + 5);
                }
            } else {
                if (IN(pb + 3 + 3 * sb)) {
                    bf16_t* ZD = (bf16_t*)(R1 + R1_ZD); bf16_t* OG = (bf16_t*)(WSB + WS_OG); float* LSE = (float*)(WSB + WS_LSE);
                    REPS(7) {
                    for (int id = bid; id < 1536; id += G) {
                        const int g = id >> 9, rem = id & 511; const int dsh = 2 * g, dil = 1 << dsh, L = SEQ >> dsh, nqb = L >> 8;
                        const int qb = rem % nqb, r2 = rem / nqb, h = r2 & 15, r = r2 >> 4;
                        at::Item it; const size_t tok0 = (size_t)sb * SEQ + r;
                        const bf16_t* zb = ZD + ((size_t)(g * 3 * 16 + h) * SEQ + (size_t)r * L) * 128;
                        it.Q = zb; it.K = zb + (size_t)16 * SEQ * 128; it.V = zb + (size_t)32 * SEQ * 128; it.qs = it.ks = it.vs = 128;
                        it.O = OG + ((size_t)g * T + tok0) * DM + h * 128; it.os = (long)dil * DM; it.LSE = LSE + ((size_t)g * T + tok0) * 16 + h; it.ls = (long)dil * 16;
                        it.i0 = qb * 256; it.W = 129; it.L = L; it.o_f8 = 0;
                        at::attn_block<128>(it, (LAS char*)lds);
                    }
                    REPB(7); }
                    SEAM(pb + 3 + 3 * sb);
                }
            }
        }
        if (!mla && IN(pb + 7)) { REPS(8) { dil_combine_phase((const bf16_t*)(WSB + WS_OG), (const float*)(WSB + WS_LSE), OB); REPB(8); } SEAM(pb + 7); }
        if (IN(pb + 8)) {
            pg8::Gemm g{OB, (const bf16_t*)(WSB + (mla ? WS_WO_MLA : WS_WO_DIL)), T, DM, DM / 2};
            pg8::EpiResGate E{xcur, modl + 2 * DM, 6 * DM, (bf16_t*)XA, DM, 1.f / (ACT_F8SCALE * DIL_WSCALE), layer > 0};
            pg8::StaticOrder S; S.init(g.M, g.N, G, bid);
            REPS(9) { pg8::gemm_phase<pg8::EpiResGate, pg8::StaticOrder, true>(lds, g, S, E); REPB(9); }
            SEAM(pb + 8);
        }
        if (IN(pb + 9)) {
            REPS(10) { norm_phase(XA, A.norm_g + (size_t)(layer * 2 + 1) * DM, modl, 3 * DM, 4 * DM, HB, 0, R1  , 1);
            tables_phase(A.peer_u + (size_t)layer * PEER_E * DM, A.peer_v + (size_t)layer * PEER_E * DM, WSB + WS_UTAB, WSB + WS_VTAB, (float*)(WSB + WS_USC), (float*)(WSB + WS_USC) + 1); REPB(10); }
            SEAM(pb + 9);
        }
        if (IN(pb + 10)) {
            pg8::Gemm g{HB, (const bf16_t*)(WSB + WS_WQ) + (size_t)layer * DM * DM, T, DM, DM};
            pg8::EpiBf16 E{PQ, DM, 2, nullptr, nullptr, nullptr, nullptr, nullptr, 1.f, nullptr};
            pg8::StaticOrder S; S.init(g.M, g.N, G, bid);
            REPS(11) { pg8::gemm_phase<pg8::EpiBf16, pg8::StaticOrder>(lds, g, S, E); REPB(11); }
            SEAM(pb + 10);
        }
        if (IN(pb + 11)) { REPS(12) { route_phase(PQ, (const bf16_t*)(WSB + WS_SUBK) + (size_t)layer * 8 * 2 * 128 * 128, IDX, GATE, lds); REPB(12); } SEAM(pb + 11); }
        if (IN(pb + 12)) {
            REPS(13) { peer_phase(R1, IDX, GATE, WSB + WS_UTAB, WSB + WS_VTAB, (const float*)(WSB + WS_USC), (const float*)(WSB + WS_VSC), XA, modl + 5 * DM, xout, layer + 1 < DEPTH, lds); REPB(13); }
            SEAM(pb + 12);
        }
    }
#undef IN
#undef SEAM
#undef REPS
#undef REPB
}

#undef WSB
#undef HB
#undef XA
#undef XB
#undef PQ
#undef IDX
#undef GATE
#undef R1
extern "C" void kernel_launch(void* const* d_in, const int* in_sizes, int n_in, void* d_out, int out_size, void* d_ws, size_t ws_size, hipStream_t stream) {
    static int grid = 0;
    if (grid == 0) {
        if (n_in != 22 || out_size != T * DM || ws_size < WS_END) { fprintf(stderr, "kernel_launch: unexpected shapes (n_in %d out %d ws %zu need %zu)\n", n_in, out_size, ws_size, (size_t)WS_END); grid = -1; return; }
        int dev = 0, cus = 0, per_cu = 0;
        if (hipGetDevice(&dev) != hipSuccess || hipDeviceGetAttribute(&cus, hipDeviceAttributeMultiprocessorCount, dev) != hipSuccess) { grid = -1; return; }
        if (hipFuncSetAttribute((const void*)fwd_kernel, hipFuncAttributeMaxDynamicSharedMemorySize, LDS_BYTES) != hipSuccess) { fprintf(stderr, "kernel_launch: hipFuncSetAttribute failed\n"); grid = -1; return; }
        if (hipOccupancyMaxActiveBlocksPerMultiprocessor(&per_cu, (const void*)fwd_kernel, 512, LDS_BYTES) != hipSuccess || per_cu < 1) { fprintf(stderr, "kernel_launch: occupancy query says %d\n", per_cu); (void)hipGetLastError(); }
        grid = cus;
    }
    if (grid < 0) return;
    (void)hipMemsetAsync((char*)d_ws + WS_CTL, 0, CTL_BYTES, stream);
    Args a{};
    a.x = (const float*)d_in[0]; a.c = (const float*)d_in[1]; a.pos = (const int*)d_in[2]; a.ada_w = (const float*)d_in[3]; a.ada_b = (const float*)d_in[4]; a.norm_g = (const float*)d_in[5];
    a.mla_w_in = (const float*)d_in[6]; a.mla_g_q = (const float*)d_in[7]; a.mla_w_uq = (const float*)d_in[8]; a.mla_g_kv = (const float*)d_in[9]; a.mla_w_ukv = (const float*)d_in[10];
    a.mla_g_qn = (const float*)d_in[11]; a.mla_g_kn = (const float*)d_in[12]; a.mla_w_o = (const float*)d_in[13];
    a.dil_w_in = (const float*)d_in[14]; a.dil_g_qn = (const float*)d_in[15]; a.dil_g_kn = (const float*)d_in[16]; a.dil_w_o = (const float*)d_in[17];
    a.peer_w_q = (const float*)d_in[18]; a.peer_sub_keys = (const float*)d_in[19]; a.peer_u = (const float*)d_in[20]; a.peer_v = (const float*)d_in[21];
    a.out = (float*)d_out; a.ws = (unsigned char*)d_ws;
#if MK_ONE_LAUNCH
    a.ph_lo = 0; a.ph_hi = NPH;
    hipLaunchKernelGGL(fwd_kernel, dim3(grid), dim3(512), LDS_BYTES, stream, a);
#else
    for (int ph = 0; ph < NPH; ++ph) {
        if (!phase_exists(ph)) continue;
        a.ph_lo = ph; a.ph_hi = ph + 1;
        hipLaunchKernelGGL(fwd_kernel, dim3(grid), dim3(512), LDS_BYTES, stream, a);
    }
#endif
}

#ifdef PHASE_AUDIT
#define AUD_LDS extern __shared__ __attribute__((aligned(16))) unsigned char lds_raw[]; LAS unsigned char* lds = (LAS unsigned char*)lds_raw
__global__ void __launch_bounds__(512, 2) aud_prologue(Args A) { AUD_LDS; prologue_phase(A, lds); }
__global__ void __launch_bounds__(512, 2) aud_norm(Args A) { norm_phase(A.x, A.norm_g, A.ada_b, 0, DM, (bf16_t*)A.ws, A.ph_lo); }
__global__ void __launch_bounds__(512, 2) aud_gemm_bf16(Args A) { AUD_LDS; pg8::Gemm g{(const bf16_t*)A.ws, (const bf16_t*)A.ws + 1000000, T, A.ph_lo, A.ph_hi}; pg8::EpiBf16 E{(bf16_t*)A.out, A.ph_lo, A.ph_hi & 1, (const unsigned*)A.x, A.c, A.ada_b, A.norm_g, (LAS float*)(lds + LDS_XCH), 1.f, nullptr}; pg8::StaticOrder S; S.init(g.M, g.N, gridDim.x, blockIdx.x); pg8::gemm_phase<pg8::EpiBf16, pg8::StaticOrder>(lds, g, S, E); }
__global__ void __launch_bounds__(512, 2) aud_gemm_f8(Args A) { AUD_LDS; pg8::Gemm g{(const bf16_t*)A.ws, (const bf16_t*)A.ws + 1000000, T, A.ph_lo, A.ph_hi}; pg8::EpiBf16 E{(bf16_t*)A.out, A.ph_lo, A.ph_hi & 1, (const unsigned*)A.x, A.c, A.ada_b, A.norm_g, (LAS float*)(lds + LDS_XCH), 0.5f, nullptr}; pg8::StaticOrder S; S.init(g.M, g.N, gridDim.x, blockIdx.x); pg8::gemm_phase<pg8::EpiBf16, pg8::StaticOrder, true>(lds, g, S, E); }
__global__ void __launch_bounds__(512, 2) aud_gemm_res(Args A) { AUD_LDS; pg8::Gemm g{(const bf16_t*)A.ws, (const bf16_t*)A.ws + 1000000, T, A.ph_lo, A.ph_hi}; pg8::EpiResGate E{A.x, A.c, 6 * DM, (bf16_t*)A.out, DM, 0.5f, A.ph_lo}; pg8::StaticOrder S; S.init(g.M, g.N, gridDim.x, blockIdx.x); pg8::gemm_phase<pg8::EpiResGate, pg8::StaticOrder>(lds, g, S, E); }
__global__ void __launch_bounds__(512, 2) aud_cnorm(Args A) { mla_cnorm_phase((const bf16_t*)A.ws, A.mla_g_q, A.mla_g_kv, (unsigned char*)A.out, (unsigned char*)A.out + 100000); }
__global__ void __launch_bounds__(512, 2) aud_qkv(Args A) { mla_qkv_phase((const bf16_t*)A.ws, (const bf16_t*)A.ws + 1000, (const bf16_t*)A.ws + 2000, A.pos, A.mla_g_qn, A.mla_g_kn, (bf16_t*)A.out, (bf16_t*)A.out + 1000); }
__global__ void __launch_bounds__(512, 2) aud_comb(Args A) { dil_combine_phase((const bf16_t*)A.ws, A.x, (bf16_t*)A.out); }
__global__ void __launch_bounds__(512, 2) aud_attn192(Args A) { AUD_LDS; at::Item it; it.Q = (const bf16_t*)A.ws; it.K = it.Q + 1000; it.V = it.Q + 2000; it.O = (bf16_t*)A.out; it.LSE = nullptr; it.qs = 192; it.ks = 192; it.vs = 128; it.os = DM; it.ls = 0; it.i0 = A.ph_lo * 256; it.W = 1 << 30; it.L = SEQ; it.o_f8 = A.ph_hi & 1; at::attn_block<192>(it, (LAS char*)lds); }
__global__ void __launch_bounds__(512, 2) aud_attn128(Args A) { AUD_LDS; at::Item it; it.Q = (const bf16_t*)A.ws; it.K = it.Q + 1000; it.V = it.Q + 2000; it.O = (bf16_t*)A.out; it.LSE = (float*)A.out + 5000; it.qs = A.ph_hi; it.ks = A.ph_hi; it.vs = A.ph_hi; it.os = DM; it.ls = 16; it.i0 = A.ph_lo * 256; it.W = 129; it.L = SEQ; it.o_f8 = 0; at::attn_block<128>(it, (LAS char*)lds); }
__global__ void __launch_bounds__(512, 2) aud_route(Args A) { AUD_LDS; route_phase((const bf16_t*)A.ws, (const bf16_t*)A.ws + 100000, (int*)A.out, A.out + 100000, lds); }
__global__ void __launch_bounds__(512, 2) aud_peer(Args A) { AUD_LDS; peer_phase((const unsigned char*)A.ws, A.pos, A.x, A.ws + 1000, A.ws + 2000, A.c, A.c, A.c, A.ada_b, A.out, A.ph_lo, lds); }
#endif
```

```cpp
#include <hip/hip_runtime.h>
#include <stdint.h>
#include <stdio.h>

#ifndef MK_ONE_LAUNCH
#define MK_ONE_LAUNCH 1
#endif
#ifndef REP_MASK
#define REP_MASK 0
#endif

#define LAS __attribute__((address_space(3)))
typedef unsigned short bf16_t;
typedef short bf16x8 __attribute__((ext_vector_type(8)));
typedef short s16x4 __attribute__((ext_vector_type(4)));
typedef float f32x4 __attribute__((ext_vector_type(4)));
typedef float f32x2 __attribute__((ext_vector_type(2)));
typedef float f32x16 __attribute__((ext_vector_type(16)));
typedef unsigned u32x4 __attribute__((ext_vector_type(4)));
typedef unsigned u32x2 __attribute__((ext_vector_type(2)));
typedef int i32x4 __attribute__((ext_vector_type(4)));
using bf16x2_t = __attribute__((ext_vector_type(2))) __bf16;

constexpr int DM = 2048, NB = 2, SEQ = 8192, T = NB * SEQ, DEPTH = 2;
constexpr int MLA_H = 16, MLA_QR = 512, MLA_KVR = 512, MLA_NOPE = 128, MLA_ROPE = 64, MLA_QK = 192, MLA_V = 128, MLA_IN = 1088, MLA_IN_PAD = 1280;
constexpr int DIL_G = 3, DIL_H = 16, DIL_DH = 128, DIL_GW = 2048, DIL_IN = 18432;
constexpr int PEER_H = 8, PEER_NK = 128, PEER_E = 16384, PEER_TOPK = 16;
constexpr float EPS = 1e-6f;
constexpr float LOG2E = 1.4426950408889634f;
constexpr float ACT_F8SCALE = 64.f;
constexpr float DIL_WSCALE = 64.f;

constexpr size_t MiB = 1u << 20;
constexpr size_t al256(size_t x) { return (x + 255) & ~(size_t)255; }
constexpr size_t WS_CTL = 0, CTL_BYTES = 1 * MiB;
constexpr size_t CTL_MOD_OFF = 64 * 1024;
constexpr size_t WS_WIN_MLA = WS_CTL + CTL_BYTES;
constexpr size_t WS_WUQ = WS_WIN_MLA + al256((size_t)MLA_IN_PAD * DM * 2);
constexpr size_t WS_WUKV = WS_WUQ + al256((size_t)3072 * 512 * 2);
constexpr size_t WS_WO_MLA = WS_WUKV + al256((size_t)4096 * 512 * 2);
constexpr size_t WS_WIN_DIL = WS_WO_MLA + al256((size_t)DM * DM * 2);
constexpr size_t WS_WO_DIL = WS_WIN_DIL + al256((size_t)DIL_IN * DM * 2);
constexpr size_t WS_WQ = WS_WO_DIL + al256((size_t)DM * DM * 2);
constexpr size_t WS_SUBK = WS_WQ + al256((size_t)2 * DM * DM * 2);
constexpr size_t WS_UTAB = WS_SUBK + al256((size_t)2 * 8 * 2 * 128 * 128 * 2);
constexpr size_t WS_VTAB = WS_UTAB + al256((size_t)PEER_E * DM);
constexpr size_t WS_USC = WS_VTAB + al256((size_t)PEER_E * DM);
constexpr size_t WS_VSC = WS_USC + al256((size_t)PEER_E * 4);
constexpr size_t WS_HB = WS_VSC + al256((size_t)PEER_E * 4);
constexpr size_t WS_XA = WS_HB + al256((size_t)T * DM * 2);
constexpr size_t WS_PQ = WS_XA + (size_t)T * DM * 4;
constexpr size_t WS_XB = WS_PQ + al256((size_t)T * DM * 2);
constexpr size_t WS_IDX = WS_XB + al256((size_t)T * DM * 4);
constexpr size_t WS_GATE = WS_IDX + al256((size_t)T * 128 * 4);
constexpr size_t WS_R1 = WS_GATE + al256((size_t)T * 128 * 4);
constexpr size_t WS_QRAW = WS_XA, WS_KVRAW = WS_XB, WS_OG = WS_XA, WS_LSE = WS_IDX;
constexpr size_t R1_Z = 0;
constexpr size_t R1_CQN = R1_Z + al256((size_t)T * MLA_IN_PAD * 2);
constexpr size_t R1_CKVN = R1_CQN + al256((size_t)T * 512 * 2);
constexpr size_t R1_Q = R1_CKVN + al256((size_t)T * 512 * 2);
constexpr size_t R1_K = R1_Q + al256((size_t)T * 3072 * 2);
constexpr size_t R1_V = R1_K + al256((size_t)T * 3072 * 2);
constexpr size_t R1_END0 = R1_V + al256((size_t)T * DM * 2);
constexpr size_t R1_ZD = 0;
constexpr size_t R1_END1 = R1_ZD + al256((size_t)SEQ * DIL_IN * 2);
constexpr size_t R1_BYTES = R1_END0 > R1_END1 ? R1_END0 : R1_END1;
constexpr size_t WS_ROPE = WS_R1 + R1_BYTES;
constexpr size_t WS_END = WS_ROPE + al256((size_t)2 * T * 64 * 4);
static_assert(WS_END <= (size_t)1116430848, "workspace must fit the guaranteed minimum");

__device__ __forceinline__ float bf2f(unsigned v) { return __uint_as_float(v << 16); }
__device__ __forceinline__ unsigned cvt_pk_bf16(float lo, float hi) { unsigned r; asm volatile("s_nop 0\n\tv_cvt_pk_bf16_f32 %0, %1, %2" : "=v"(r) : "v"(lo), "v"(hi)); return r; }
__device__ __forceinline__ unsigned bf16_rne_bits(float f) { unsigned u = __float_as_uint(f); u += 0x7FFFu + ((u >> 16) & 1u); return u >> 16; }
__device__ __forceinline__ float bflo(unsigned w) { return __uint_as_float(w << 16); }
__device__ __forceinline__ float bfhi(unsigned w) { return __uint_as_float(w & 0xffff0000u); }
__device__ __forceinline__ float dot2(unsigned a, unsigned b, float acc) { return __builtin_amdgcn_fdot2_f32_bf16(__builtin_bit_cast(bf16x2_t, a), __builtin_bit_cast(bf16x2_t, b), acc, false); }
__device__ __forceinline__ float wave_sum(float v) {
#pragma unroll
    for (int o = 32; o >= 1; o >>= 1) v += __shfl_xor(v, o);
    return v;
}
__device__ __forceinline__ int otid() { int t = (int)threadIdx.x; asm volatile("" : "+v"(t)); return t; }
typedef __attribute__((address_space(1))) unsigned char* gptr_t;
__device__ __forceinline__ unsigned char* ow(unsigned char* p) { gptr_t g = (gptr_t)p; asm volatile("" : "+s"(g)); return (unsigned char*)g; }
__device__ __forceinline__ int obid() { int b = (int)blockIdx.x; asm volatile("" : "+s"(b)); return b; }
__device__ __forceinline__ u32x4 pack8f(f32x4 a, f32x4 b) { u32x4 w = {cvt_pk_bf16(a[0], a[1]), cvt_pk_bf16(a[2], a[3]), cvt_pk_bf16(b[0], b[1]), cvt_pk_bf16(b[2], b[3])}; return w; }
__device__ __forceinline__ void unpack8(u32x4 w, float (&f)[8]) { f[0] = bflo(w.x); f[1] = bfhi(w.x); f[2] = bflo(w.y); f[3] = bfhi(w.y); f[4] = bflo(w.z); f[5] = bfhi(w.z); f[6] = bflo(w.w); f[7] = bfhi(w.w); }
__device__ __forceinline__ void sincos_rev(float ang, float& s, float& c) {
    const double x = (double)ang * 0.15915494309189533577;
    const float fr = (float)(x - __builtin_rint(x));
    s = __builtin_amdgcn_sinf(fr); c = __builtin_amdgcn_cosf(fr);
}

#define XB_TMO      128
#define XB_XCNT(j)  (256  + 64 * (j))
#define XB_XSUB(j)  (1280 + 64 * (j))
#define XB_XGEN(j)  (2304 + 64 * (j))
#define XB_TOP      3328
#define XB_TOPGEN   3392
#define XCD_BAR_WORDS 3456
#define XB_SPIN_CAP (1u << 22)
__device__ __forceinline__ unsigned xb_ld(unsigned* p)              { return __hip_atomic_load(p, __ATOMIC_RELAXED, __HIP_MEMORY_SCOPE_AGENT); }
__device__ __forceinline__ unsigned xb_add(unsigned* p, unsigned v) { return __hip_atomic_fetch_add(p, v, __ATOMIC_RELAXED, __HIP_MEMORY_SCOPE_AGENT); }
__device__ __forceinline__ unsigned xb_xcc_id() { return (unsigned)__builtin_amdgcn_s_getreg((3 << 11) | 20) & 0xFu; }
#define XB_SPIN(cond, bar) do { unsigned _sp = 0; while (cond) { __builtin_amdgcn_s_sleep(1); \
    if ((++_sp & 255u) == 0u) { if (xb_ld(&(bar)[XB_TMO])) break; if (_sp > XB_SPIN_CAP) { atomicAdd(&(bar)[XB_TMO], 1u); break; } } } } while (0)
struct XcdBarrier { unsigned* bar; unsigned x; volatile LAS unsigned* st; };
__device__ __forceinline__ XcdBarrier xcd_barrier_post(unsigned* bar, volatile LAS unsigned* st) {
    XcdBarrier b; b.bar = bar; b.x = xb_xcc_id(); b.st = st;
    if (threadIdx.x == 0) (void)xb_add(&bar[XB_XCNT(b.x)], 1u);
    return b;
}
__device__ __forceinline__ void xcd_barrier_complete(unsigned* bar, unsigned x, unsigned& nloc, unsigned& nx) {
    const unsigned G = gridDim.x * gridDim.y * gridDim.z;
    unsigned sum, cnt, mine, sp = 0u;
    for (;;) {
        sum = 0u; cnt = 0u; mine = 0u;
#pragma unroll
        for (unsigned j = 0; j < 16; ++j) { const unsigned c = xb_ld(&bar[XB_XCNT(j)]); sum += c; cnt += (c > 0u) ? 1u : 0u; mine = (j == x) ? c : mine; }
        if (sum == G) break;
        __builtin_amdgcn_s_sleep(1);
        if ((++sp & 255u) == 0u) { if (xb_ld(&bar[XB_TMO])) break; if (sp > XB_SPIN_CAP) { atomicAdd(&bar[XB_TMO], 1u); break; } }
    }
    nloc = mine > 0u ? mine : 1u; nx = cnt > 0u ? cnt : 1u;
}
__device__ __forceinline__ void xcd_barrier(const XcdBarrier& b) {
    asm volatile("s_waitcnt vmcnt(0)" ::: "memory");
    __syncthreads();
    if (threadIdx.x == 0) {
        unsigned* bar = b.bar;
        __builtin_amdgcn_s_waitcnt(0);
        unsigned nloc = b.st[0], nx = b.st[1];
        if (nloc == 0u) { xcd_barrier_complete(bar, b.x, nloc, nx); b.st[0] = nloc; b.st[1] = nx; }
        const unsigned old = xb_add(&bar[XB_XSUB(b.x)], 1u);
        const unsigned gen = old / nloc;
        if (old + 1u == (gen + 1u) * nloc) {
            __builtin_amdgcn_fence(__ATOMIC_RELEASE, "agent");
            asm volatile("s_waitcnt vmcnt(0)" ::: "memory");
            const unsigned og = xb_add(&bar[XB_TOP], 1u);
            const unsigned tg = og / nx;
            if (og + 1u == (tg + 1u) * nx) xb_add(&bar[XB_TOPGEN], 1u);
            else XB_SPIN(xb_ld(&bar[XB_TOPGEN]) == tg, bar);
            __builtin_amdgcn_fence(__ATOMIC_ACQUIRE, "agent");
            xb_add(&bar[XB_XGEN(b.x)], 1u);
            asm volatile("s_waitcnt vmcnt(0)" ::: "memory");
        } else {
            XB_SPIN(xb_ld(&bar[XB_XGEN(b.x)]) == gen, bar);
            __builtin_amdgcn_fence(__ATOMIC_ACQUIRE, "agent");
            asm volatile("s_waitcnt vmcnt(0)" ::: "memory");
        }
    }
    __syncthreads();
}

namespace pg8 {
constexpr int BM = 256, BK = 64, HALF = 128, HTB = HALF * BK * 2, STAGE_BYTES = 8 * HTB, NXCD = 8, WGM = 8;
__host__ __device__ __forceinline__ int lds_byte(int r, int c) { const int st = (r >> 4) * 2 + (c >> 5), rr = r & 15, cc = c & 31, ob = rr * 64 + cc * 2; return st * 1024 + (ob ^ (((ob >> 9) & 1) << 5)); }
__host__ __device__ __forceinline__ void stage_rc(int b, int& R, int& C) { const int st = b / 1024, sb = b % 1024, swz = sb ^ (((sb >> 9) & 1) << 5); R = (st >> 1) * 16 + swz / 64; C = (st & 1) * 32 + (swz % 64) / 2; }
__host__ __device__ __forceinline__ int perm32(int rho) { const int n = rho >> 4, i = rho & 15; return 8 * (i >> 2) + 4 * n + (i & 3); }
struct Unit { int pm, pn; };
struct Gemm { const bf16_t* A; const bf16_t* Bt; int M, N, K; };
struct StaticOrder {
    int nM, nN, nwg, G, c;
    __host__ __device__ void init(int M, int N, int G_, int c_) { nM = M / BM; nN = N / BM; nwg = nM * nN; G = G_; c = c_; }
    __host__ __device__ bool next(int i, Unit& u) const {
        const long L = (long)i * G + c; if (L >= nwg) return false;
        int wgid = (int)L; { const int q = nwg / NXCD, r = nwg % NXCD, xcd = wgid % NXCD, off = wgid / NXCD; wgid = (xcd < r ? xcd * (q + 1) : r * (q + 1) + (xcd - r) * q) + off; }
        const int nig = WGM * nN, gid = wgid / nig, fm = gid * WGM, gsz = (nM - fm) < WGM ? (nM - fm) : WGM;
        u.pm = fm + ((wgid % nig) % gsz); u.pn = (wgid % nig) / gsz; return true;
    }
    __device__ __forceinline__ void a_ready(const Unit&) const {}
    __device__ __forceinline__ void done(const Unit&) const {}
};
struct EpiBf16 {
    static constexpr bool PERM = true;
    bf16_t* O; int ldc; int mode; const unsigned* cs; const float* sn; const float* g_qn; const float* g_kn; LAS float* xch; float oscale; bf16_t* O2;
    __device__ __forceinline__ void operator()(const f32x4 (&acc)[2][2][4][2], const Unit& u, int wr, int wc, int fr, int fq) const {
        { const int l_ = otid() & 63; fr = l_ & 15; fq = l_ >> 4; }
        const int row0 = u.pm * BM + wr * 64 + fr; const int col0 = u.pn * BM + wc * 32 + 8 * fq;
        if (mode == 2) {
#pragma unroll
            for (int ai = 0; ai < 2; ++ai)
#pragma unroll
                for (int m = 0; m < 4; ++m) { const int r = row0 + ai * HALF + m * 16;
#pragma unroll
                    for (int bj = 0; bj < 2; ++bj) { const f32x4 v0 = acc[ai][bj][m][0] * oscale, v1 = acc[ai][bj][m][1] * oscale;
                        u32x4 w; w.x = cvt_pk_bf16(v0[0], v0[1]); w.y = cvt_pk_bf16(v0[2], v0[3]); w.z = cvt_pk_bf16(v1[0], v1[1]); w.w = cvt_pk_bf16(v1[2], v1[3]);
                        const int d0 = wc * 32 + 8 * fq;
                        *(u32x4*)(O + ((size_t)(((r >> 5) * 8 + u.pn) * 2 + bj) << 12) + (size_t)(((d0 >> 4) * 64 + ((d0 >> 3) & 1) * 32 + (r & 31)) * 8)) = w; } }
            return;
        }
        if (mode == 0) {
#pragma unroll
            for (int ai = 0; ai < 2; ++ai)
#pragma unroll
                for (int m = 0; m < 4; ++m) { bf16_t* rowp = O + (size_t)(row0 + ai * HALF + m * 16) * ldc + col0;
#pragma unroll
                    for (int bj = 0; bj < 2; ++bj) { const f32x4 v0 = acc[ai][bj][m][0] * oscale, v1 = acc[ai][bj][m][1] * oscale;
                        u32x4 w; w.x = cvt_pk_bf16(v0[0], v0[1]); w.y = cvt_pk_bf16(v0[2], v0[3]); w.z = cvt_pk_bf16(v1[0], v1[1]); w.w = cvt_pk_bf16(v1[2], v1[3]);
                        if (bj == 1 && O2 != nullptr) { const int r = row0 + ai * HALF + m * 16;
                            *(u32x4*)(O2 + ((size_t)((r >> 13) * MLA_H + u.pn) * SEQ + (r & (SEQ - 1))) * 128 + wc * 32 + 8 * fq) = w; }
                        else *(u32x4*)(rowp + bj * HALF) = w; } }
            return;
        }
        const int mg = 4 * wc + fq;
        u32x4 csv[2][4];
#pragma unroll
        for (int ai = 0; ai < 2; ++ai)
#pragma unroll
            for (int m = 0; m < 4; ++m) { const int r_ = row0 + ai * HALF + m * 16; csv[ai][m] = *(const u32x4*)(cs + ((size_t)((r_ >> 4) * 16 + mg) * 16 + (r_ & 15)) * 4); }
#pragma unroll
        for (int ai = 0; ai < 2; ++ai)
#pragma unroll
            for (int m = 0; m < 4; ++m)
#pragma unroll
                for (int bj = 0; bj < 2; ++bj) { const f32x4 a0 = acc[ai][bj][m][0], a1 = acc[ai][bj][m][1];
                    float s = (a0[0] * a0[0] + a0[1] * a0[1]) + (a0[2] * a0[2] + a0[3] * a0[3]) + (a1[0] * a1[0] + a1[1] * a1[1]) + (a1[2] * a1[2] + a1[3] * a1[3]);
                    s += __shfl_xor(s, 16); s += __shfl_xor(s, 32); s *= oscale * oscale;
                    if (fq == 0) xch[(((((wr * 2 + ai) * 4 + m) * 16 + fr) * 2 + bj) << 2) + wc] = s; }
        asm volatile("s_waitcnt lgkmcnt(0)" ::: "memory"); __builtin_amdgcn_s_barrier(); asm volatile("" ::: "memory");
        const float QSC = 0.08838834764831845f * 1.4426950408889634f;
#pragma unroll
        for (int bj = 0; bj < 2; ++bj) {
            const int hh = 2 * u.pn + bj, typ = (hh >> 4) % 3, grp = hh / 48;
            const int dsh = 2 * grp, lsh = 13 - dsh;
            bf16_t* hbase = O + (size_t)hh * SEQ * 128 + wc * 32 + 8 * fq;
#define ZROW(s_) ((size_t)((((s_) & ((1 << dsh) - 1)) << lsh) + ((s_) >> dsh)) * 128)
            if (typ == 2) {
#pragma unroll
                for (int ai = 0; ai < 2; ++ai)
#pragma unroll
                    for (int m = 0; m < 4; ++m) { const f32x4 v0 = acc[ai][bj][m][0] * oscale, v1 = acc[ai][bj][m][1] * oscale;
                        u32x4 w; w.x = cvt_pk_bf16(v0[0], v0[1]); w.y = cvt_pk_bf16(v0[2], v0[3]); w.z = cvt_pk_bf16(v1[0], v1[1]); w.w = cvt_pk_bf16(v1[2], v1[3]);
                        *(u32x4*)(hbase + ZROW(row0 + ai * HALF + m * 16)) = w; }
            } else {
                const float* gp = (typ == 0 ? g_qn : g_kn) + grp * 128 + 4 * mg; const float qs = typ == 0 ? QSC : 1.f;
                const f32x4 g1 = *(const f32x4*)gp * qs, g2 = *(const f32x4*)(gp + 64) * qs;
#pragma unroll
                for (int ai = 0; ai < 2; ++ai)
#pragma unroll
                    for (int m = 0; m < 4; ++m) { const int rl = ai * HALF + m * 16;
                        const f32x4 part = *(const LAS f32x4*)(xch + (((((wr * 2 + ai) * 4 + m) * 16 + fr) * 2 + bj) << 2));
                        const float rinv = rsqrtf(((part[0] + part[1]) + (part[2] + part[3])) * (1.f / 128) + 1e-6f) * oscale;
                        const u32x4 cw = csv[ai][m]; const f32x4 c4 = {bflo(cw.x), bflo(cw.y), bflo(cw.z), bflo(cw.w)}, s4 = {bfhi(cw.x), bfhi(cw.y), bfhi(cw.z), bfhi(cw.w)};
                        const f32x4 y1 = acc[ai][bj][m][0] * rinv * g1, y2 = acc[ai][bj][m][1] * rinv * g2;
                        const f32x4 o1 = y1 * c4 - y2 * s4, o2 = y2 * c4 + y1 * s4;
                        u32x4 w; w.x = cvt_pk_bf16(o1[0], o1[1]); w.y = cvt_pk_bf16(o1[2], o1[3]); w.z = cvt_pk_bf16(o2[0], o2[1]); w.w = cvt_pk_bf16(o2[2], o2[3]);
                        *(u32x4*)(hbase + ZROW(row0 + rl)) = w; }
            }
#undef ZROW
        }
    }
};
struct EpiResGate {
    static constexpr bool PERM = true;
    const float* base; const float* gate; int gate_bstride; bf16_t* out; int ldc; float oscale; int base_b16;
    __device__ __forceinline__ void operator()(const f32x4 (&acc)[2][2][4][2], const Unit& u, int wr, int wc, int fr, int fq) const {
        { const int l_ = otid() & 63; fr = l_ & 15; fq = l_ >> 4; }
        const int row0 = u.pm * BM + wr * 64 + fr, col0 = u.pn * BM + wc * 32 + 8 * fq;
        const float* gp = gate + (size_t)((u.pm * BM) / SEQ) * gate_bstride + col0;
        f32x4 gv[2][2];
#pragma unroll
        for (int bj = 0; bj < 2; ++bj)
#pragma unroll
            for (int n = 0; n < 2; ++n) gv[bj][n] = *(const f32x4*)(gp + bj * HALF + n * 4) * oscale;
#pragma unroll
        for (int ai = 0; ai < 2; ++ai) {
            f32x4 bs[4][2][2];
#pragma unroll
            for (int m = 0; m < 4; ++m) { const size_t off = (size_t)(row0 + ai * HALF + m * 16) * ldc + col0;
#pragma unroll
                for (int bj = 0; bj < 2; ++bj) {
                    if (base_b16) { const u32x4 w_ = *(const u32x4*)((const bf16_t*)base + off + bj * HALF);
                        bs[m][bj][0] = f32x4{bflo(w_.x), bfhi(w_.x), bflo(w_.y), bfhi(w_.y)}; bs[m][bj][1] = f32x4{bflo(w_.z), bfhi(w_.z), bflo(w_.w), bfhi(w_.w)}; }
                    else { bs[m][bj][0] = *(const f32x4*)(base + off + bj * HALF); bs[m][bj][1] = *(const f32x4*)(base + off + bj * HALF + 4); } } }
            asm volatile("" ::: "memory");
#pragma unroll
            for (int m = 0; m < 4; ++m) { const size_t off = (size_t)(row0 + ai * HALF + m * 16) * ldc + col0;
#pragma unroll
                for (int bj = 0; bj < 2; ++bj) { const f32x4 o0 = bs[m][bj][0] + gv[bj][0] * acc[ai][bj][m][0], o1 = bs[m][bj][1] + gv[bj][1] * acc[ai][bj][m][1];
                    *(u32x4*)(out + off + bj * HALF) = u32x4{cvt_pk_bf16(o0[0], o0[1]), cvt_pk_bf16(o0[2], o0[3]), cvt_pk_bf16(o1[0], o1[1]), cvt_pk_bf16(o1[2], o1[3])}; } }
            asm volatile("" ::: "memory"); }
    }
};
typedef int i32x8 __attribute__((ext_vector_type(8)));
typedef int i32x4v __attribute__((ext_vector_type(4)));
template <class Epi, class Sched, bool F8 = false>
__device__ __forceinline__ void gemm_phase(LAS unsigned char* lds, const Gemm g, const Sched& S, const Epi& E) {
    const int tid = otid(), wid = __builtin_amdgcn_readfirstlane(tid >> 6), lane = tid & 63, wr = wid >> 2, wc = wid & 3, fr = lane & 15, fq = lane >> 4;
    const int K = g.K, nt = K / BK;
    unsigned voffA[2], voffB[2];
#pragma unroll
    for (int i = 0; i < 2; ++i) { int R, C; stage_rc(tid * 16 + i * 8192, R, C); const int Rb = Epi::PERM ? ((R & ~31) + perm32(R & 31)) : R;
        voffA[i] = (unsigned)(R * K + C) * 2u; voffB[i] = (unsigned)(Rb * K + C) * 2u; }
    const size_t kstep = (size_t)(BK * 2);
    const size_t hstep = (size_t)HALF * K * 2;
    const size_t tstep = 2 * hstep;
    const unsigned ldsw = (unsigned)wid * 1024u;
    const int aoff = lds_byte(wr * 64 + fr, fq * 8), boff = lds_byte(wc * 32 + fr, fq * 8);
#define PG8_SA(b, h) (((b) * 2 + (h)) * HTB)
#define PG8_SB(b, h) ((4 + (b) * 2 + (h)) * HTB)
#define PG8_STAGE(bufoff, gbase, voff) do { _Pragma("unroll") for (int _i = 0; _i < 2; ++_i) \
        __builtin_amdgcn_global_load_lds((const unsigned*)((const char*)(gbase) + (voff)[_i]), (LAS unsigned*)(lds + (bufoff) + ldsw + _i * 8192), 16, 0, 0); } while (0)
#define PG8_LDA(dst, b, h) do { if constexpr (F8) { _Pragma("unroll") for (int m = 0; m < 4; ++m) { const i32x4v lo_ = *(const LAS i32x4v*)(lds + PG8_SA(b, h) + aoff + m * 2048), hi_ = *(const LAS i32x4v*)(lds + PG8_SA(b, h) + aoff + m * 2048 + 1024); \
            dst##8[m] = __builtin_shufflevector(lo_, hi_, 0, 1, 2, 3, 4, 5, 6, 7); } } \
        else { _Pragma("unroll") for (int m = 0; m < 4; ++m) _Pragma("unroll") for (int k = 0; k < 2; ++k) dst[m][k] = *(const LAS bf16x8*)(lds + PG8_SA(b, h) + aoff + m * 2048 + k * 1024); } } while (0)
#define PG8_LDB(dst, b, h) do { if constexpr (F8) { _Pragma("unroll") for (int n = 0; n < 2; ++n) { const i32x4v lo_ = *(const LAS i32x4v*)(lds + PG8_SB(b, h) + boff + n * 2048), hi_ = *(const LAS i32x4v*)(lds + PG8_SB(b, h) + boff + n * 2048 + 1024); \
            dst##8[n] = __builtin_shufflevector(lo_, hi_, 0, 1, 2, 3, 4, 5, 6, 7); } } \
        else { _Pragma("unroll") for (int n = 0; n < 2; ++n) _Pragma("unroll") for (int k = 0; k < 2; ++k) dst[n][k] = *(const LAS bf16x8*)(lds + PG8_SB(b, h) + boff + n * 2048 + k * 1024); } } while (0)
#define PG8_MMA(ai, bj, At, Bt) do { __builtin_amdgcn_s_setprio(1); _Pragma("unroll") for (int m = 0; m < 4; ++m) _Pragma("unroll") for (int n = 0; n < 2; ++n) { \
        if constexpr (F8) asm volatile("v_mfma_scale_f32_16x16x128_f8f6f4 %0, %1, %2, %0, %3, %3 op_sel_hi:[0,0,0]" : "+v"(acc[ai][bj][m][n]) : "v"(Bt##8[n]), "v"(At##8[m]), "v"(mxs));   \
        else { _Pragma("unroll") for (int k = 0; k < 2; ++k) acc[ai][bj][m][n] = __builtin_amdgcn_mfma_f32_16x16x32_bf16(Bt[n][k], At[m][k], acc[ai][bj][m][n], 0, 0, 0); } } \
        __builtin_amdgcn_s_setprio(0); } while (0)
#define PG8_WAIT_V(n) asm volatile("s_waitcnt vmcnt(" #n ")" ::: "memory")
#define PG8_WAIT_L(n) asm volatile("s_waitcnt lgkmcnt(" #n ")" ::: "memory")
#define PG8_BAR __builtin_amdgcn_s_barrier()
#define PG8_SCHED __builtin_amdgcn_sched_barrier(0)
    Unit cur, nxt; int ui = 0;
    if (!S.next(0, cur)) return;
    f32x4 acc[2][2][4][2];
#pragma unroll
    for (int a = 0; a < 2; ++a)
#pragma unroll
        for (int b = 0; b < 2; ++b)
#pragma unroll
            for (int m = 0; m < 4; ++m)
#pragma unroll
                for (int n = 0; n < 2; ++n) acc[a][b][m][n] = (f32x4){0.f, 0.f, 0.f, 0.f};
    bf16x8 At[4][2], B0[2][2], B1[2][2]; i32x8 At8[4], B08[2], B18[2];
    int mxs = 0x7F7F7F7F; asm volatile("" : "+v"(mxs));
    const char* cA = (const char*)g.A + (size_t)cur.pm * tstep; const char* cB = (const char*)g.Bt + (size_t)cur.pn * tstep;
    S.a_ready(cur);
    PG8_STAGE(PG8_SB(0, 0), cB, voffB); PG8_STAGE(PG8_SA(0, 0), cA, voffA); PG8_STAGE(PG8_SB(0, 1), cB + hstep, voffB); PG8_STAGE(PG8_SA(0, 1), cA + hstep, voffA);
    if (wr == 1) PG8_BAR;
    PG8_WAIT_V(4); PG8_BAR;
    PG8_STAGE(PG8_SB(1, 0), cB + kstep, voffB); PG8_STAGE(PG8_SA(1, 0), cA + kstep, voffA); PG8_STAGE(PG8_SB(1, 1), cB + hstep + kstep, voffB);
    PG8_WAIT_V(6); PG8_BAR;
    for (;;) {
        const bool has_next = S.next(ui + 1, nxt);
        const char* nA = has_next ? (const char*)g.A + (size_t)nxt.pm * tstep : cA; const char* nB = has_next ? (const char*)g.Bt + (size_t)nxt.pn * tstep : cB;
        for (int t = 0; t < nt; t += 2) {
            const bool last = (t == nt - 2);
            const char* a1 = cA + (size_t)(t + 1) * kstep;
            const char* a2 = last ? nA : cA + (size_t)(t + 2) * kstep; const char* b2 = last ? nB : cB + (size_t)(t + 2) * kstep;
            const char* a3 = a2 + kstep; const char* b3 = b2 + kstep;
            if (last && has_next) S.a_ready(nxt);
            PG8_LDB(B0, 0, 0); PG8_SCHED; PG8_LDA(At, 0, 0); PG8_STAGE(PG8_SA(1, 1), a1 + hstep, voffA);
            PG8_WAIT_L(8); PG8_BAR; PG8_WAIT_L(0); PG8_MMA(0, 0, At, B0); PG8_BAR; PG8_SCHED;
            PG8_LDB(B1, 0, 1); PG8_STAGE(PG8_SB(0, 0), b2, voffB);
            PG8_BAR; PG8_WAIT_L(0); PG8_MMA(0, 1, At, B1); PG8_BAR;
            PG8_LDA(At, 0, 1); PG8_STAGE(PG8_SA(0, 0), a2, voffA);
            PG8_BAR; PG8_WAIT_L(0); PG8_MMA(1, 0, At, B0); PG8_BAR; PG8_SCHED;
            PG8_STAGE(PG8_SB(0, 1), b2 + hstep, voffB);
            PG8_WAIT_V(6); PG8_BAR; PG8_MMA(1, 1, At, B1); PG8_BAR;
            PG8_LDB(B0, 1, 0); PG8_SCHED; PG8_LDA(At, 1, 0); PG8_STAGE(PG8_SA(0, 1), a2 + hstep, voffA);
            PG8_WAIT_L(8); PG8_BAR; PG8_WAIT_L(0); PG8_MMA(0, 0, At, B0); PG8_BAR; PG8_SCHED;
            PG8_LDB(B1, 1, 1); PG8_STAGE(PG8_SB(1, 0), b3, voffB);
            PG8_BAR; PG8_WAIT_L(0); PG8_MMA(0, 1, At, B1); PG8_BAR;
            PG8_LDA(At, 1, 1); PG8_STAGE(PG8_SA(1, 0), a3, voffA);
            PG8_BAR; PG8_WAIT_L(0); PG8_MMA(1, 0, At, B0); PG8_BAR; PG8_SCHED;
            PG8_STAGE(PG8_SB(1, 1), b3 + hstep, voffB);
            PG8_WAIT_V(6); PG8_BAR; PG8_MMA(1, 1, At, B1); PG8_BAR;
        }
        if (wr == 0) PG8_BAR;
        if constexpr (F8) asm volatile("s_nop 15\n\ts_nop 15" ::: "memory");
        E(acc, cur, wr, wc, fr, fq); S.done(cur);
        if (!has_next) break;
#pragma unroll
        for (int a = 0; a < 2; ++a)
#pragma unroll
            for (int b = 0; b < 2; ++b)
#pragma unroll
                for (int m = 0; m < 4; ++m)
#pragma unroll
                    for (int n = 0; n < 2; ++n) acc[a][b][m][n] = (f32x4){0.f, 0.f, 0.f, 0.f};
        cur = nxt; cA = nA; cB = nB; ++ui;
        if (wr == 1) PG8_BAR;
    }
    PG8_WAIT_V(0);
    PG8_BAR;
#undef PG8_SA
#undef PG8_SB
#undef PG8_STAGE
#undef PG8_LDA
#undef PG8_LDB
#undef PG8_MMA
#undef PG8_WAIT_V
#undef PG8_WAIT_L
#undef PG8_BAR
#undef PG8_SCHED
}
}

namespace at {
constexpr int SHM_V = 64 * 128 * 2;
constexpr float THR = 8.f;
#define SBAR() __builtin_amdgcn_sched_barrier(0)
__device__ __forceinline__ int v_st(int k, int c) { const int kk = (k & ~0xC) | ((k & 4) << 1) | ((k & 8) >> 1); return ((kk >> 3) * 4 + (c >> 5)) * 512 + ((kk & 7) * 32 + (c & 31)) * 2; }
__device__ __forceinline__ int v_rd_base(int lane) { return ((lane & 3) << 3) | (((lane >> 2) & 3) << 6) | (((lane >> 4) & 1) << 5) | (((lane >> 5) & 1) << 8); }
constexpr int v_rd_off(int d0, int ks, int half) { return d0 * 512 + ks * 4096 + half * 2048; }
__device__ __forceinline__ int crow(int r, int hi) { return (r & 3) + 8 * (r >> 2) + 4 * hi; }
__device__ __forceinline__ void mask_tile(f32x16& p0, f32x16& p1, int dq, unsigned W) {
    const float NEG = -__builtin_inff();
#pragma unroll
    for (int r = 0; r < 16; ++r) {
        const int c = (r & 3) + 8 * (r >> 2);
        if ((unsigned)(dq - c) >= W) p0[r] = NEG;
        if ((unsigned)(dq - c - 32) >= W) p1[r] = NEG;
    }
}
__device__ __forceinline__ void partialSM(f32x16& p0, f32x16& p1, float& m_reg, float& alpha) {
    float pmax = p0[0];
#pragma unroll
    for (int r = 1; r < 16; ++r) pmax = fmaxf(pmax, p0[r]);
#pragma unroll
    for (int r = 0; r < 16; ++r) pmax = fmaxf(pmax, p1[r]);
    { auto rr = __builtin_amdgcn_permlane32_swap(__float_as_uint(pmax), __float_as_uint(pmax), false, false);
      pmax = fmaxf(__uint_as_float(rr[0]), __uint_as_float(rr[1])); }
    float mn;
    if (__builtin_expect(__all((pmax - m_reg) <= THR), 1)) { mn = m_reg; alpha = 1.f; }
    else { mn = fmaxf(m_reg, pmax); alpha = __builtin_amdgcn_exp2f(m_reg - mn); m_reg = mn; }
#pragma unroll
    for (int r = 0; r < 16; ++r) p0[r] = __builtin_amdgcn_exp2f(p0[r] - mn);
#pragma unroll
    for (int r = 0; r < 16; ++r) p1[r] = __builtin_amdgcn_exp2f(p1[r] - mn);
}
__device__ __forceinline__ void finishSM(f32x16& p0, f32x16& p1, float alpha, float& l_reg, bf16x8& pa0, bf16x8& pa1, bf16x8& pa2, bf16x8& pa3) {
    float ps = 0;
#pragma unroll
    for (int r = 0; r < 16; ++r) ps += p0[r];
#pragma unroll
    for (int r = 0; r < 16; ++r) ps += p1[r];
    { auto rr = __builtin_amdgcn_permlane32_swap(__float_as_uint(ps), __float_as_uint(ps), false, false);
      ps = __uint_as_float(rr[0]) + __uint_as_float(rr[1]); }
    l_reg = l_reg * alpha + ps;
#define PK4(P, B_, OUT) do { unsigned a0 = cvt_pk_bf16(P[B_+0], P[B_+1]), a1 = cvt_pk_bf16(P[B_+2], P[B_+3]);                          \
        unsigned b0 = cvt_pk_bf16(P[B_+4], P[B_+5]), b1 = cvt_pk_bf16(P[B_+6], P[B_+7]);                                             \
        auto r0 = __builtin_amdgcn_permlane32_swap(a0, b0, false, false); auto r1 = __builtin_amdgcn_permlane32_swap(a1, b1, false, false); \
        u32x4 w = {r0[0], r1[0], r0[1], r1[1]}; OUT = *reinterpret_cast<bf16x8*>(&w); } while (0)
    PK4(p0, 0, pa0); PK4(p0, 8, pa1); PK4(p1, 0, pa2); PK4(p1, 8, pa3);
#undef PK4
}
template <int KP, int ND>
__device__ __forceinline__ void qkt(f32x16& p0, f32x16& p1, const LAS char* Kb, int r32, int hi, const bf16x8* qr) {
    p0 = f32x16{}; p1 = f32x16{};
    __builtin_amdgcn_s_setprio(1);
    const LAS char* ka = Kb + r32 * KP + hi * 16;
#pragma unroll
    for (int d0 = 0; d0 < ND; ++d0) {
        const bf16x8 b0 = *reinterpret_cast<const LAS bf16x8*>(ka + d0 * 32);
        const bf16x8 b1 = *reinterpret_cast<const LAS bf16x8*>(ka + 32 * KP + d0 * 32);
        p0 = __builtin_amdgcn_mfma_f32_32x32x16_bf16(b0, qr[d0], p0, 0, 0, 0);
        p1 = __builtin_amdgcn_mfma_f32_32x32x16_bf16(b1, qr[d0], p1, 0, 0, 0);
        if ((d0 & 3) == 3) SBAR(); }
    __builtin_amdgcn_s_setprio(0);
}
template <int VB>
__device__ __forceinline__ void pv_tile(f32x16* o, int vb0, bf16x8 pa0, bf16x8 pa1, bf16x8 pa2, bf16x8 pa3) {
#define TRRD(dst, off) asm volatile("ds_read_b64_tr_b16 %0, %1 offset:%2" : "=&v"(dst) : "v"(vb0), "i"(off) : "memory")
#define PV_D0(d0) do { s16x4 l0, l1, l2, l3, h0, h1, h2, h3; constexpr int b_ = VB * SHM_V + v_rd_off(d0, 0, 0); \
        TRRD(l0, b_); TRRD(h0, b_ + 2048); TRRD(l1, b_ + 4096); TRRD(h1, b_ + 6144); TRRD(l2, b_ + 8192); TRRD(h2, b_ + 10240); TRRD(l3, b_ + 12288); TRRD(h3, b_ + 14336); \
        asm volatile("s_waitcnt lgkmcnt(0)" ::: "memory"); SBAR();   \
        o[d0] = __builtin_amdgcn_mfma_f32_32x32x16_bf16(pa0, (bf16x8){l0[0], l0[1], l0[2], l0[3], h0[0], h0[1], h0[2], h0[3]}, o[d0], 0, 0, 0);   \
        o[d0] = __builtin_amdgcn_mfma_f32_32x32x16_bf16(pa1, (bf16x8){l1[0], l1[1], l1[2], l1[3], h1[0], h1[1], h1[2], h1[3]}, o[d0], 0, 0, 0);   \
        o[d0] = __builtin_amdgcn_mfma_f32_32x32x16_bf16(pa2, (bf16x8){l2[0], l2[1], l2[2], l2[3], h2[0], h2[1], h2[2], h2[3]}, o[d0], 0, 0, 0);   \
        o[d0] = __builtin_amdgcn_mfma_f32_32x32x16_bf16(pa3, (bf16x8){l3[0], l3[1], l3[2], l3[3], h3[0], h3[1], h3[2], h3[3]}, o[d0], 0, 0, 0); } while (0)
    PV_D0(0); PV_D0(1); PV_D0(2); PV_D0(3);
#undef PV_D0
#undef TRRD
}
struct Item { const bf16_t* Q; const bf16_t* K; const bf16_t* V; bf16_t* O; float* LSE; long qs, ks, vs, os, ls; int i0, W, L, o_f8; };
template <int DQK>
__device__ __forceinline__ void attn_block(const Item& it, LAS char* lds) {
    constexpr int KP = DQK * 2 + 16, KBYTES = 64 * KP, ND = DQK / 16, CPR = DQK / 8, NKC = (64 * CPR) / 512;
    const int tid = otid(), wid = __builtin_amdgcn_readfirstlane(tid >> 6), lane = tid & 63, r32 = lane & 31, hi = lane >> 5;
    LAS char* V_lds = lds; LAS char* K_lds = lds + 3 * SHM_V;
    LAS float* wsf = (LAS float*)(lds + 3 * SHM_V + 3 * KBYTES) + wid * 64; LAS float* li_l = wsf; LAS float* al_l = wsf + 32;
    const int W = it.W, i0 = it.i0;
    const int qlo = i0 + wid * 32, qm = qlo + r32 - 4 * hi;
    const int lowk = i0 - (W - 1); const int j_lo = lowk > 0 ? lowk / 64 : 0;
    int j_hi = (i0 + 255) / 64 + 1; if (j_hi > it.L / 64) j_hi = it.L / 64;
    const int NT = j_hi - j_lo;
    bf16x8 qr[ND];
    { const bf16_t* qrow = it.Q + (size_t)(qlo + r32) * it.qs + hi * 8;
#pragma unroll
      for (int d0 = 0; d0 < ND; ++d0) qr[d0] = *reinterpret_cast<const bf16x8*>(qrow + d0 * 16); }
    unsigned kgo[NKC], klo[NKC];
#pragma unroll
    for (int i = 0; i < NKC; ++i) { const int c = tid + 512 * i, kr_ = c / CPR, kc_ = c % CPR; kgo[i] = (unsigned)(kr_ * (int)it.ks * 2 + kc_ * 16); klo[i] = (unsigned)(kr_ * KP + kc_ * 16); }
    const int sr = tid >> 4, sc = (tid & 15) * 8, vst0 = v_st(sr, sc), vst1 = v_st(32 + sr, sc);
    const unsigned vgo0 = (unsigned)(sr * (int)it.vs * 2 + sc * 2), vgo1 = (unsigned)((32 + sr) * (int)it.vs * 2 + sc * 2);
    const int vb0 = (int)(uintptr_t)V_lds + v_rd_base(lane);
    bf16x8 stK[NKC], stV0, stV1;
#define AT_LOAD(t) do { const char* kt_ = (const char*)it.K + (size_t)(j_lo + (t)) * 64 * it.ks * 2; const char* vt_ = (const char*)it.V + (size_t)(j_lo + (t)) * 64 * it.vs * 2; \
        _Pragma("unroll") for (int i = 0; i < NKC; ++i) stK[i] = *reinterpret_cast<const bf16x8*>(kt_ + (size_t)kgo[i]); \
        stV0 = *reinterpret_cast<const bf16x8*>(vt_ + (size_t)vgo0); stV1 = *reinterpret_cast<const bf16x8*>(vt_ + (size_t)vgo1); } while (0)
#define AT_WRITE(bf) do { _Pragma("unroll") for (int i = 0; i < NKC; ++i) *reinterpret_cast<LAS bf16x8*>(K_lds + (bf) * KBYTES + klo[i]) = stK[i]; \
        *reinterpret_cast<LAS bf16x8*>(V_lds + (bf) * SHM_V + vst0) = stV0; *reinterpret_cast<LAS bf16x8*>(V_lds + (bf) * SHM_V + vst1) = stV1; } while (0)
    float m_reg = -1e30f, l_reg = 0.f; f32x16 o[4] = {};
    const bool late = wid >= 4;
    f32x16 p0, p1; bool pend = false;
#define AT_PRO() do { AT_LOAD(0); AT_WRITE(0); if (NT > 1) AT_LOAD(1); __syncthreads(); } while (0)
#define AT_SMPV(BFV) do { float alpha; bf16x8 pa0, pa1, pa2, pa3; \
        partialSM(p0, p1, m_reg, alpha); \
        if (__any(alpha < 1.f)) { if (hi == 0) al_l[r32] = alpha; asm volatile("s_waitcnt lgkmcnt(0)" ::: "memory"); \
            _Pragma("unroll") for (int d_ = 0; d_ < 4; ++d_) _Pragma("unroll") for (int r = 0; r < 16; ++r) o[d_][r] *= al_l[crow(r, hi)]; } \
        finishSM(p0, p1, alpha, l_reg, pa0, pa1, pa2, pa3); SBAR(); \
        pv_tile<BFV>(o, vb0, pa0, pa1, pa2, pa3); } while (0)
#define AT_QK(t, BF) do { const int kb = (j_lo + (t)) * 64; \
        qkt<KP, ND>(p0, p1, K_lds + (BF) * KBYTES, r32, hi, qr); \
        if (kb + 63 > qlo || kb <= qlo + 31 - W) mask_tile(p0, p1, qm - kb, (unsigned)W); } while (0)
#define AT_ACTIVE(t) ((j_lo + (t)) * 64 <= qlo + 31 && (j_lo + (t)) * 64 + 63 >= qlo - (W - 1))
#define AT_STAGE(t, BFN) do { if ((t) + 1 < NT) { AT_WRITE(BFN); if ((t) + 2 < NT) AT_LOAD((t) + 2); } } while (0)
    if (!late) {
        asm volatile("; early half" ::: "memory"); AT_PRO();
#define AT_STEP(t, BF, BFN) do { AT_STAGE(t, BFN); if (AT_ACTIVE(t)) { AT_QK(t, BF); AT_SMPV(BF); } __syncthreads(); } while (0)
        for (int t = 0; t < NT; t += 3) {
            AT_STEP(t, 0, 1);
            if (t + 1 < NT) AT_STEP(t + 1, 1, 2);
            if (t + 2 < NT) AT_STEP(t + 2, 2, 0);
        }
#undef AT_STEP
    } else {
        asm volatile("; late half" ::: "memory"); AT_PRO();
#define AT_STEP(t, BF, BFN, BFP) do { AT_STAGE(t, BFN); if (pend) { AT_SMPV(BFP); } pend = AT_ACTIVE(t); if (pend) { AT_QK(t, BF); } __syncthreads(); } while (0)
        for (int t = 0; t < NT; t += 3) {
            AT_STEP(t, 0, 1, 2);
            if (t + 1 < NT) AT_STEP(t + 1, 1, 2, 0);
            if (t + 2 < NT) AT_STEP(t + 2, 2, 0, 1);
        }
#undef AT_STEP
        if (pend) { const int lastslot = (NT - 1) % 3;
            if (lastslot == 0) AT_SMPV(0); else if (lastslot == 1) AT_SMPV(1); else AT_SMPV(2); }
    }
#undef AT_STAGE
#undef AT_PRO
#undef AT_SMPV
#undef AT_QK
#undef AT_ACTIVE
#undef AT_STEP
#undef AT_LOAD
#undef AT_WRITE
    __syncthreads();
    if (hi == 0) li_l[r32] = l_reg;
    asm volatile("s_waitcnt lgkmcnt(0)" ::: "memory");
    LAS char* ow = lds + wid * 8192;
#pragma unroll
    for (int r = 0; r < 16; ++r) { const int orow = crow(r, hi); const float rl = __builtin_amdgcn_rcpf(li_l[orow]);
#pragma unroll
        for (int d0 = 0; d0 < 4; ++d0) { const float v = o[d0][r] * rl; const float vn = __shfl_xor(v, 1);
            if ((r32 & 1) == 0) *reinterpret_cast<LAS unsigned*>(ow + orow * 256 + (d0 * 32 + r32) * 2) = cvt_pk_bf16(v, vn); } }
    asm volatile("s_waitcnt lgkmcnt(0)" ::: "memory");
#pragma unroll
    for (int k = 0; k < 8; ++k) { const int row = k * 4 + (lane >> 4), ch = lane & 15;
        const u32x4 w = *reinterpret_cast<const LAS u32x4*>(ow + row * 256 + ch * 16);
        if (it.o_f8) { float f[8]; unpack8(w, f);
            int q0 = __builtin_amdgcn_cvt_pk_fp8_f32(f[0] * ACT_F8SCALE, f[1] * ACT_F8SCALE, 0, false); q0 = __builtin_amdgcn_cvt_pk_fp8_f32(f[2] * ACT_F8SCALE, f[3] * ACT_F8SCALE, q0, true);
            int q1 = __builtin_amdgcn_cvt_pk_fp8_f32(f[4] * ACT_F8SCALE, f[5] * ACT_F8SCALE, 0, false); q1 = __builtin_amdgcn_cvt_pk_fp8_f32(f[6] * ACT_F8SCALE, f[7] * ACT_F8SCALE, q1, true);
            u32x2 w8 = {(unsigned)q0, (unsigned)q1}; *(u32x2*)((unsigned char*)it.O + (size_t)(qlo + row) * it.os + ch * 8) = w8; }
        else *(u32x4*)(it.O + (size_t)(qlo + row) * it.os + ch * 8) = w; }
    if (it.LSE != nullptr && hi == 0) it.LSE[(size_t)(qlo + r32) * it.ls] = m_reg + __builtin_amdgcn_logf(l_reg);
    __syncthreads();
}
}

struct Args {
    const float* x; const float* c; const int* pos; const float* ada_w; const float* ada_b; const float* norm_g;
    const float* mla_w_in; const float* mla_g_q; const float* mla_w_uq; const float* mla_g_kv; const float* mla_w_ukv; const float* mla_g_qn; const float* mla_g_kn; const float* mla_w_o;
    const float* dil_w_in; const float* dil_g_qn; const float* dil_g_kn; const float* dil_w_o;
    const float* peer_w_q; const float* peer_sub_keys; const float* peer_u; const float* peer_v;
    float* out; unsigned char* ws; int ph_lo, ph_hi;
};
constexpr int LDS_MAIN = 128 * 1024, LDS_XCH = LDS_MAIN + 1024, LDS_BYTES = LDS_XCH + 8192;

struct TrJob { const float* src; bf16_t* dst; int K, N, Npad; int perm; float f8scale; };
__device__ __forceinline__ void tr_load(const TrJob& j, int u, int ntk, int tid, f32x4 (&v)[4]) {
    const int k0 = (u % ntk) * 128, n0 = (u / ntk) * 64, r = tid >> 4, c4 = (tid & 15) * 4;
    int sc = n0 + c4;
    if (j.perm && ((sc >> 11) % 3) < 2) { const int p = sc & 127, mgrp = p >> 3; sc = (sc & ~127) + ((p & 4) ? 64 + 4 * mgrp : 4 * mgrp); }
#pragma unroll
    for (int q2 = 0; q2 < 4; ++q2) { v[q2] = (f32x4){0.f, 0.f, 0.f, 0.f}; if (n0 + c4 < j.N) v[q2] = __builtin_nontemporal_load((const f32x4*)(j.src + (size_t)(k0 + r + 32 * q2) * j.N + sc)); }
}
__device__ __forceinline__ void transpose_job(const TrJob& j, int u0, int G, LAS float* tile) {
    const int tid = otid(); const int ntk = j.K / 128, nt = ntk * (j.Npad / 64);
    if (u0 >= nt) return;
    f32x4 v[4]; tr_load(j, u0, ntk, tid, v);
    for (int u = u0; u < nt; u += G) {
        const int k0 = (u % ntk) * 128, n0 = (u / ntk) * 64;
        { const int r = tid >> 4, c4 = (tid & 15) * 4;
#pragma unroll
          for (int q2 = 0; q2 < 4; ++q2) { const int rr = r + 32 * q2; tile[rr * 65 + c4 + 0] = v[q2][0]; tile[rr * 65 + c4 + 1] = v[q2][1]; tile[rr * 65 + c4 + 2] = v[q2][2]; tile[rr * 65 + c4 + 3] = v[q2][3]; } }
        __syncthreads();
        if (u + G < nt) tr_load(j, u + G, ntk, tid, v);
        { const int n = tid >> 3, k16 = (tid & 7) * 16; float f[16];
#pragma unroll
          for (int e = 0; e < 16; ++e) f[e] = tile[(k16 + e) * 65 + n];
          if (j.f8scale != 0.f) { const float sc_ = j.f8scale; unsigned p[4];
#pragma unroll
              for (int q = 0; q < 4; ++q) { int t_ = __builtin_amdgcn_cvt_pk_fp8_f32(f[4 * q] * sc_, f[4 * q + 1] * sc_, 0, false); t_ = __builtin_amdgcn_cvt_pk_fp8_f32(f[4 * q + 2] * sc_, f[4 * q + 3] * sc_, t_, true); p[q] = (unsigned)t_; }
              *(u32x4*)((unsigned char*)j.dst + (size_t)(n0 + n) * j.K + k0 + k16) = u32x4{p[0], p[1], p[2], p[3]}; }
          else { u32x4 w0 = {cvt_pk_bf16(f[0], f[1]), cvt_pk_bf16(f[2], f[3]), cvt_pk_bf16(f[4], f[5]), cvt_pk_bf16(f[6], f[7])}, w1 = {cvt_pk_bf16(f[8], f[9]), cvt_pk_bf16(f[10], f[11]), cvt_pk_bf16(f[12], f[13]), cvt_pk_bf16(f[14], f[15])};
              *(u32x4*)(j.dst + (size_t)(n0 + n) * j.K + k0 + k16) = w0; *(u32x4*)(j.dst + (size_t)(n0 + n) * j.K + k0 + k16 + 8) = w1; } }
        __syncthreads();
    }
}
__device__ __forceinline__ void convert_flat(const float* src, bf16_t* dst, size_t n, size_t i0, size_t stride) {
    for (size_t i = i0 * 8; i < n; i += stride * 8) { const f32x4 a = *(const f32x4*)(src + i), b = *(const f32x4*)(src + i + 4); *(u32x4*)(dst + i) = pack8f(a, b); }
}
__device__ __forceinline__ void prologue_phase(const Args& A, LAS unsigned char* lds) {
    const int tid = otid(), G = gridDim.x, bid = obid();
    unsigned char* ws = A.ws;
    { LAS float* sl = (LAS float*)lds;
      LAS float* part = sl + 2 * DM;
      float* MOD = (float*)(ws + WS_CTL + CTL_MOD_OFF);
      for (int u = bid; u < 2 * 96; u += G) {
          const int l = u / 96, cc = u % 96;
          __syncthreads();
          for (int i = tid; i < 2 * DM; i += 512) { const float v = A.c[i]; sl[i] = v / (1.f + __expf(-v)); }
          __syncthreads();
          const int c4 = tid & 31, dg = tid >> 5; const int col = cc * 128 + 4 * c4;
          f32x4 a0 = {0.f, 0.f, 0.f, 0.f}, a1 = {0.f, 0.f, 0.f, 0.f};
          const float* wp = A.ada_w + ((size_t)l * DM + dg) * (6 * DM) + col;
#pragma unroll 1
          for (int i0 = 0; i0 < 128; i0 += 16) {
              f32x4 w[16];
#pragma unroll
              for (int k = 0; k < 16; ++k) w[k] = __builtin_nontemporal_load((const f32x4*)(wp + (size_t)(i0 + k) * 16 * (6 * DM)));
#pragma unroll
              for (int k = 0; k < 16; ++k) { const int d = dg + 16 * (i0 + k); a0 += w[k] * sl[d]; a1 += w[k] * sl[DM + d]; }
          }
          *(LAS f32x4*)(part + (dg * 2 + 0) * 128 + 4 * c4) = a0; *(LAS f32x4*)(part + (dg * 2 + 1) * 128 + 4 * c4) = a1;
          __syncthreads();
          if (tid < 256) { const int b = tid >> 7, cq = tid & 127; float s = A.ada_b[l * 6 * DM + cc * 128 + cq];
#pragma unroll
              for (int g2 = 0; g2 < 16; ++g2) s += part[(g2 * 2 + b) * 128 + cq];
              MOD[((size_t)l * 2 + b) * 6 * DM + cc * 128 + cq] = s; }
      }
      __syncthreads(); }
    { int base = 0;
#define TR_JOB(SRC, DST, KK, NN, NP, PM, F8S) do { TrJob j; j.src = (SRC); j.dst = (DST); j.K = (KK); j.N = (NN); j.Npad = (NP); j.perm = (PM); j.f8scale = (F8S); const int nt = (j.K / 128) * (j.Npad / 64); \
          int u = bid - (base % G); if (u < 0) u += G; transpose_job(j, u, G, (LAS float*)lds); base += nt; } while (0)
      TR_JOB(A.mla_w_in, (bf16_t*)(ws + WS_WIN_MLA), DM, MLA_IN, MLA_IN_PAD, 0, DIL_WSCALE);
      TR_JOB(A.mla_w_uq, (bf16_t*)(ws + WS_WUQ), 512, 3072, 3072, 0, DIL_WSCALE);
      TR_JOB(A.mla_w_ukv, (bf16_t*)(ws + WS_WUKV), 512, 4096, 4096, 0, DIL_WSCALE);
      TR_JOB(A.mla_w_o, (bf16_t*)(ws + WS_WO_MLA), DM, DM, DM, 0, DIL_WSCALE);
      TR_JOB(A.dil_w_in, (bf16_t*)(ws + WS_WIN_DIL), DM, DIL_IN, DIL_IN, 1, DIL_WSCALE);
      TR_JOB(A.dil_w_o, (bf16_t*)(ws + WS_WO_DIL), DM, DM, DM, 0, DIL_WSCALE);
      TR_JOB(A.peer_w_q, (bf16_t*)(ws + WS_WQ), DM, DM, DM, 0, 0.f);
      TR_JOB(A.peer_w_q + (size_t)DM * DM, (bf16_t*)(ws + WS_WQ) + (size_t)DM * DM, DM, DM, DM, 0, 0.f);
#undef TR_JOB
    }
    { const size_t i0 = (size_t)bid * 512 + tid, stride = (size_t)G * 512;
      { bf16_t* sk = (bf16_t*)(ws + WS_SUBK);
        for (size_t i = i0 * 8; i < (size_t)2 * 8 * 2 * 128 * 128; i += stride * 8) { const f32x4 a = *(const f32x4*)(A.peer_sub_keys + i), b = *(const f32x4*)(A.peer_sub_keys + i + 4);
            const size_t blk = i >> 14; const int w_ = (int)(i & 16383), key = w_ >> 7, d0 = w_ & 127;
            const size_t o_ = (blk << 14) + (size_t)((((key >> 5) * 8 + (d0 >> 4)) * 64 + ((d0 >> 3) & 1) * 32 + (key & 31)) * 8);
            *(u32x4*)(sk + o_) = pack8f(a, b); } }
      unsigned* csT = (unsigned*)(ws + WS_ROPE);
      for (size_t i = i0; i < (size_t)T * 64; i += stride) { const int tok = (int)(i >> 6), fi = (int)(i & 63); const float inv = exp2f(-(float)fi * (13.287712379549449f / 64.f));
          float s_, c_; sincos_rev((float)A.pos[tok] * inv, s_, c_); csT[(((size_t)(tok >> 4) * 16 + (fi >> 2)) * 16 + (tok & 15)) * 4 + (fi & 3)] = bf16_rne_bits(c_) | (bf16_rne_bits(s_) << 16); } }
}
__device__ __forceinline__ void table_row_store(const f32x4 (&v)[8], float mx, int e, unsigned char* __restrict__ dst, float* __restrict__ scales, int lane) {
#pragma unroll
    for (int o = 32; o >= 1; o >>= 1) mx = fmaxf(mx, __shfl_xor(mx, o));
    const int ex = (int)((__float_as_uint(mx) >> 23) & 0xff);
    const float scale = ex == 0 ? 1.f : __uint_as_float((unsigned)(ex - 7 > 1 ? ex - 7 : 1) << 23);
    const float inv = 1.f / scale;
    if (lane == 0) scales[e] = scale;
#pragma unroll
    for (int k = 0; k < 8; ++k) { int p = __builtin_amdgcn_cvt_pk_fp8_f32(v[k][0] * inv, v[k][1] * inv, 0, false); p = __builtin_amdgcn_cvt_pk_fp8_f32(v[k][2] * inv, v[k][3] * inv, p, true);
        const int c = 2 * k + (lane >> 5); *(int*)(dst + ((size_t)c * PEER_E + e) * 128 + 4 * (lane & 31)) = p; }
}
__device__ __forceinline__ void table_row_store4(const f32x4 (&v)[8], float mx, float ss, int e, unsigned char* __restrict__ dst, float* __restrict__ scales, int lane) {
#pragma unroll
    for (int o = 32; o >= 1; o >>= 1) { mx = fmaxf(mx, __shfl_xor(mx, o)); ss += __shfl_xor(ss, o); }
    float scale = fmaxf(sqrtf(ss * (1.f / DM)) * (1.f / 2.1f), mx * 0.125f);
    if (!(scale > 0.f)) scale = 1.f;
    const float inv = 1.f / scale;
    if (lane == 0) scales[2 * e] = scale;
#pragma unroll
    for (int k = 0; k < 8; ++k) { unsigned p = __builtin_amdgcn_cvt_scalef32_pk_fp4_f32(0u, v[k][0] * inv, v[k][1] * inv, 1.0f, 0); p = __builtin_amdgcn_cvt_scalef32_pk_fp4_f32(p, v[k][2] * inv, v[k][3] * inv, 1.0f, 1);
        *(unsigned short*)(dst + ((size_t)k * PEER_E + e) * 128 + 2 * lane) = (unsigned short)p; }
}
__device__ __forceinline__ void table_rows_fp8(const float* __restrict__ src, unsigned char* __restrict__ dst, float* __restrict__ scales, int bid, int nb, int wv, int lane, bool f4) {
    for (int run = bid; run < PEER_E / 64; run += nb) {
#pragma unroll 1
        for (int i = 0; i < 8; i += 2) {
            const int e0 = run * 64 + wv * 8 + i, e1 = e0 + 1;
            f32x4 va[8], vb[8]; float ma = 0.f, mb = 0.f;
#pragma unroll
            for (int k = 0; k < 8; ++k) { va[k] = __builtin_nontemporal_load((const f32x4*)(src + (size_t)e0 * DM + k * 256 + lane * 4)); vb[k] = __builtin_nontemporal_load((const f32x4*)(src + (size_t)e1 * DM + k * 256 + lane * 4)); }
#pragma unroll
            for (int k = 0; k < 8; ++k) { ma = fmaxf(ma, fmaxf(fmaxf(fabsf(va[k][0]), fabsf(va[k][1])), fmaxf(fabsf(va[k][2]), fabsf(va[k][3])))); mb = fmaxf(mb, fmaxf(fmaxf(fabsf(vb[k][0]), fabsf(vb[k][1])), fmaxf(fabsf(vb[k][2]), fabsf(vb[k][3])))); }
            if (f4) { float sa_ = 0.f, sb_ = 0.f;
#pragma unroll
                for (int k = 0; k < 8; ++k) { sa_ += (va[k][0] * va[k][0] + va[k][1] * va[k][1]) + (va[k][2] * va[k][2] + va[k][3] * va[k][3]); sb_ += (vb[k][0] * vb[k][0] + vb[k][1] * vb[k][1]) + (vb[k][2] * vb[k][2] + vb[k][3] * vb[k][3]); }
                table_row_store4(va, ma, sa_, e0, dst, scales, lane); table_row_store4(vb, mb, sb_, e1, dst, scales, lane); }
            else { table_row_store(va, ma, e0, dst, scales, lane); table_row_store(vb, mb, e1, dst, scales, lane); }
        }
    }
}
__device__ __forceinline__ void tables_phase(const float* u, const float* v, unsigned char* U, unsigned char* V, float* usc, float* vsc) {
    const int tid_ = otid(), lane = tid_ & 63, wv = tid_ >> 6, bid = obid(), nb = gridDim.x;
    table_rows_fp8(u, U, usc, bid, nb, wv, lane, true); table_rows_fp8(v, V, vsc, bid, nb, wv, lane, true);
}

__device__ __forceinline__ void norm_phase(const float* __restrict__ xin, const float* __restrict__ gain, const float* __restrict__ modl  , int shift_off, int scale_off, bf16_t* __restrict__ out, int f8  , unsigned char* __restrict__ out8b = nullptr  , int inb16 = 0  ) {
    const int tid_ = otid(), lane = tid_ & 63, gw = obid() * 8 + (tid_ >> 6), nw = gridDim.x * 8;
    unsigned char* out8 = (unsigned char*)out;
    for (int row0 = gw; row0 < T; row0 += 2 * nw) {
        const int row1 = row0 + nw; const bool has1 = row1 < T; const int r1 = has1 ? row1 : row0;
        const float* xa = xin + (size_t)row0 * DM; const float* xb = xin + (size_t)r1 * DM; f32x4 va[8], vb[8]; float sa = 0.f, sb = 0.f;
#pragma unroll
        for (int j = 0; j < 4; ++j) {
            const int c8 = j * 512 + lane * 8;
            if (inb16) { const u32x4 wa_ = *(const u32x4*)((const bf16_t*)xin + (size_t)row0 * DM + c8), wb_ = *(const u32x4*)((const bf16_t*)xin + (size_t)r1 * DM + c8);
                va[2 * j] = f32x4{bflo(wa_.x), bfhi(wa_.x), bflo(wa_.y), bfhi(wa_.y)}; va[2 * j + 1] = f32x4{bflo(wa_.z), bfhi(wa_.z), bflo(wa_.w), bfhi(wa_.w)};
                vb[2 * j] = f32x4{bflo(wb_.x), bfhi(wb_.x), bflo(wb_.y), bfhi(wb_.y)}; vb[2 * j + 1] = f32x4{bflo(wb_.z), bfhi(wb_.z), bflo(wb_.w), bfhi(wb_.w)}; }
            else { va[2 * j] = *(const f32x4*)(xa + c8); va[2 * j + 1] = *(const f32x4*)(xa + c8 + 4); vb[2 * j] = *(const f32x4*)(xb + c8); vb[2 * j + 1] = *(const f32x4*)(xb + c8 + 4); } }
#pragma unroll
        for (int k = 0; k < 8; ++k) { sa += va[k][0] * va[k][0] + va[k][1] * va[k][1] + va[k][2] * va[k][2] + va[k][3] * va[k][3]; sb += vb[k][0] * vb[k][0] + vb[k][1] * vb[k][1] + vb[k][2] * vb[k][2] + vb[k][3] * vb[k][3]; }
        sa = wave_sum(sa); sb = wave_sum(sb); const float ra = rsqrtf(sa * (1.f / DM) + EPS), rb = rsqrtf(sb * (1.f / DM) + EPS);
        const float* ma = modl + (size_t)(row0 >> 13) * 6 * DM; const float* mb = modl + (size_t)(r1 >> 13) * 6 * DM;
#pragma unroll
        for (int j = 0; j < 4; ++j) { const int c8 = j * 512 + lane * 8;
#pragma unroll
            for (int rw = 0; rw < 2; ++rw) { if (rw == 1 && !has1) break;
                const float* mm = rw ? mb : ma; const float rr = rw ? rb : ra; const size_t ro = (size_t)(rw ? row1 : row0) * DM + c8;
                f32x4 y[2];
#pragma unroll
                for (int hh = 0; hh < 2; ++hh) { const int c = c8 + 4 * hh; const f32x4 g = *(const f32x4*)(gain + c), sc = *(const f32x4*)(mm + scale_off + c), sh = *(const f32x4*)(mm + shift_off + c);
                    y[hh] = (rw ? vb[2 * j + hh] : va[2 * j + hh]) * rr * g * (1.f + sc) + sh; }
                int p0 = __builtin_amdgcn_cvt_pk_fp8_f32(y[0][0], y[0][1], 0, false); p0 = __builtin_amdgcn_cvt_pk_fp8_f32(y[0][2], y[0][3], p0, true);
                int p1 = __builtin_amdgcn_cvt_pk_fp8_f32(y[1][0], y[1][1], 0, false); p1 = __builtin_amdgcn_cvt_pk_fp8_f32(y[1][2], y[1][3], p1, true);
                if (f8) *(u32x2*)(out8 + ro) = u32x2{(unsigned)p0, (unsigned)p1};
                else { *(u32x4*)(out + ro) = u32x4{cvt_pk_bf16(y[0][0], y[0][1]), cvt_pk_bf16(y[0][2], y[0][3]), cvt_pk_bf16(y[1][0], y[1][1]), cvt_pk_bf16(y[1][2], y[1][3])};
                       if (out8b) *(u32x2*)(out8b + ro) = u32x2{(unsigned)p0, (unsigned)p1}; } } }
    }
}

__device__ __forceinline__ void mla_cnorm_phase(const bf16_t* Z, const float* g_q, const float* g_kv, unsigned char* CQN, unsigned char* CKVN) {
    const int tid_ = otid(), lane = tid_ & 63, gw = obid() * 8 + (tid_ >> 6), nw = gridDim.x * 8;
    float gq[8], gk[8];
#pragma unroll
    for (int e = 0; e < 8; ++e) { gq[e] = g_q[lane * 8 + e]; gk[e] = g_kv[lane * 8 + e]; }
    for (int row = gw; row < T; row += nw) {
        const u32x4 a = *(const u32x4*)(Z + (size_t)row * MLA_IN_PAD + lane * 8), b = *(const u32x4*)(Z + (size_t)row * MLA_IN_PAD + 512 + lane * 8);
        float fa[8], fb[8]; unpack8(a, fa); unpack8(b, fb); float sa = 0.f, sb = 0.f;
#pragma unroll
        for (int e = 0; e < 8; ++e) { sa += fa[e] * fa[e]; sb += fb[e] * fb[e]; }
        sa = wave_sum(sa); sb = wave_sum(sb); const float ra = rsqrtf(sa * (1.f / 512) + EPS), rb = rsqrtf(sb * (1.f / 512) + EPS);
#pragma unroll
        for (int e = 0; e < 8; ++e) { fa[e] *= ra * gq[e]; fb[e] *= rb * gk[e]; }
        int a0 = __builtin_amdgcn_cvt_pk_fp8_f32(fa[0], fa[1], 0, false); a0 = __builtin_amdgcn_cvt_pk_fp8_f32(fa[2], fa[3], a0, true);
        int a1 = __builtin_amdgcn_cvt_pk_fp8_f32(fa[4], fa[5], 0, false); a1 = __builtin_amdgcn_cvt_pk_fp8_f32(fa[6], fa[7], a1, true);
        int b0 = __builtin_amdgcn_cvt_pk_fp8_f32(fb[0], fb[1], 0, false); b0 = __builtin_amdgcn_cvt_pk_fp8_f32(fb[2], fb[3], b0, true);
        int b1 = __builtin_amdgcn_cvt_pk_fp8_f32(fb[4], fb[5], 0, false); b1 = __builtin_amdgcn_cvt_pk_fp8_f32(fb[6], fb[7], b1, true);
        u32x2 wa = {(unsigned)a0, (unsigned)a1}, wb = {(unsigned)b0, (unsigned)b1};
        *(u32x2*)(CQN + (size_t)row * 512 + lane * 8) = wa; *(u32x2*)(CKVN + (size_t)row * 512 + lane * 8) = wb;
    }
}

__device__ __forceinline__ void mla_qkv_phase(const bf16_t* __restrict__ QRAW, const bf16_t* __restrict__ KVRAW, const bf16_t* __restrict__ Z, const int* __restrict__ pos, const float* __restrict__ g_qn, const float* __restrict__ g_kn,
                                              bf16_t* __restrict__ Q, bf16_t* __restrict__ K) {
    const int tid_ = otid(), lane = tid_ & 63, gw = obid() * 8 + (tid_ >> 6), nw = gridDim.x * 8;
    const int sub = lane & 31, hsel = lane >> 5;
    const bool isn = sub < 16, isr = sub >= 16 && sub < 24, act = sub < 24;
    const int e0 = isn ? sub * 8 : (128 + (sub - 16) * 8);
    float gq[8], gk[8];
#pragma unroll
    for (int e = 0; e < 8; ++e) { gq[e] = act ? g_qn[e0 + e] : 0.f; gk[e] = act ? g_kn[e0 + e] : 0.f; }
    const float QSC = 0.07216878364870322f * LOG2E;
    for (int row = gw; row < T; row += nw) {
        const int b = row >> 13, s = row & (SEQ - 1);
        float cs[8], sn[8];
        { const float p = (float)pos[row];
#pragma unroll
          for (int e = 0; e < 8; ++e) { const int fi = ((sub & 3) * 8 + e); const float inv = exp2f(-(float)fi * (13.287712379549449f / 32.f)); sincos_rev(p * inv, sn[e], cs[e]); } }
        u32x4 kr = {0u, 0u, 0u, 0u}; if (isr) kr = *(const u32x4*)(Z + (size_t)row * MLA_IN_PAD + 1024 + (sub - 16) * 8);
#pragma unroll 1
        for (int p4 = 0; p4 < 2; ++p4) {
            u32x4 wq[4], wk[4];
#pragma unroll
            for (int i = 0; i < 4; ++i) { const int h = (p4 * 4 + i) * 2 + hsel;
                wq[i] = (u32x4){0u, 0u, 0u, 0u}; if (act) wq[i] = *(const u32x4*)(QRAW + (size_t)row * 3072 + h * 192 + e0);
                wk[i] = kr; if (isn) wk[i] = *(const u32x4*)(KVRAW + (size_t)row * 4096 + h * 256 + sub * 8); }
#pragma unroll
            for (int i = 0; i < 4; ++i) { const int h = (p4 * 4 + i) * 2 + hsel;
#pragma unroll
                for (int qk = 0; qk < 2; ++qk) {
                    float f[8]; unpack8(qk == 0 ? wq[i] : wk[i], f); float ss = 0.f;
#pragma unroll
                    for (int e = 0; e < 8; ++e) ss += f[e] * f[e];
#pragma unroll
                    for (int o = 16; o >= 1; o >>= 1) ss += __shfl_xor(ss, o);
                    const float r = rsqrtf(ss * (1.f / 192) + EPS) * (qk == 0 ? QSC : 1.f);
#pragma unroll
                    for (int e = 0; e < 8; ++e) f[e] *= r * (qk == 0 ? gq[e] : gk[e]);
                    float y[8];
#pragma unroll
                    for (int e = 0; e < 8; ++e) { const float px = __shfl_xor(f[e], 4); y[e] = isr ? ((sub < 20) ? (f[e] * cs[e] - px * sn[e]) : (f[e] * cs[e] + px * sn[e])) : f[e]; }
                    if (act) { u32x4 o = {cvt_pk_bf16(y[0], y[1]), cvt_pk_bf16(y[2], y[3]), cvt_pk_bf16(y[4], y[5]), cvt_pk_bf16(y[6], y[7])};
                        *(u32x4*)((qk == 0 ? Q : K) + ((size_t)(b * MLA_H + h) * SEQ + s) * 192 + e0) = o; }
                }
            }
        }
    }
}

__device__ __forceinline__ void dil_combine_phase(const bf16_t* OG, const float* LSE, bf16_t* O) {
    const int tid_ = otid(), lane = tid_ & 63, gw = obid() * 8 + (tid_ >> 6), nw = gridDim.x * 8;
    for (int row = gw; row < T; row += nw) {
#pragma unroll
        for (int k = 0; k < 2; ++k) {
            const int col = k * 1024 + lane * 16, h = col >> 7;
            const float l0 = LSE[((size_t)0 * T + row) * 16 + h], l1 = LSE[((size_t)1 * T + row) * 16 + h], l2 = LSE[((size_t)2 * T + row) * 16 + h];
            const float mx = fmaxf(l0, fmaxf(l1, l2)); float w0 = exp2f(l0 - mx), w1 = exp2f(l1 - mx), w2 = exp2f(l2 - mx); const float inv = 1.f / (w0 + w1 + w2); w0 *= inv; w1 *= inv; w2 *= inv;
            unsigned q[4];
#pragma unroll
            for (int hh = 0; hh < 2; ++hh) { float a[8], b[8], c[8];
                unpack8(*(const u32x4*)(OG + ((size_t)0 * T + row) * DM + col + 8 * hh), a); unpack8(*(const u32x4*)(OG + ((size_t)1 * T + row) * DM + col + 8 * hh), b); unpack8(*(const u32x4*)(OG + ((size_t)2 * T + row) * DM + col + 8 * hh), c);
                float y[8];
#pragma unroll
                for (int e = 0; e < 8; ++e) y[e] = w0 * a[e] + w1 * b[e] + w2 * c[e];
                int q0 = __builtin_amdgcn_cvt_pk_fp8_f32(y[0] * ACT_F8SCALE, y[1] * ACT_F8SCALE, 0, false); q0 = __builtin_amdgcn_cvt_pk_fp8_f32(y[2] * ACT_F8SCALE, y[3] * ACT_F8SCALE, q0, true);
                int q1 = __builtin_amdgcn_cvt_pk_fp8_f32(y[4] * ACT_F8SCALE, y[5] * ACT_F8SCALE, 0, false); q1 = __builtin_amdgcn_cvt_pk_fp8_f32(y[6] * ACT_F8SCALE, y[7] * ACT_F8SCALE, q1, true);
                q[2 * hh] = (unsigned)q0; q[2 * hh + 1] = (unsigned)q1; }
            *(u32x4*)((unsigned char*)O + (size_t)row * DM + col) = u32x4{q[0], q[1], q[2], q[3]};
        }
    }
}

namespace rt {
__device__ __forceinline__ int f2key(float s) { const int u = (int)__float_as_uint(s); return u ^ (int)((unsigned)(u >> 31) >> 1); }
__device__ __forceinline__ float key2f(int k) { return __uint_as_float((unsigned)(k ^ (int)((unsigned)(k >> 31) >> 1))); }
template <int N> __device__ __forceinline__ void sort_desc(int (&v)[N]) {
#pragma unroll
    for (int k = 2; k <= N; k <<= 1) {
#pragma unroll
        for (int j = k >> 1; j > 0; j >>= 1) {
#pragma unroll
            for (int i = 0; i < N; ++i) { const int l = i ^ j;
                if (l > i) { const bool desc = ((i & k) == 0); const int a = v[i], b = v[l]; const int mx = a > b ? a : b, mn = a > b ? b : a; v[i] = desc ? mx : mn; v[l] = desc ? mn : mx; } }
        }
    }
}
__device__ __forceinline__ void bitonic_merge_desc16(int (&v)[16]) {
#pragma unroll
    for (int j = 8; j > 0; j >>= 1) {
#pragma unroll
        for (int i = 0; i < 16; ++i) { const int l = i ^ j; if (l > i) { const int a = v[i], b = v[l]; v[i] = a > b ? a : b; v[l] = a > b ? b : a; } }
    }
}
__device__ __forceinline__ void merge_top16(int (&a)[16], const int (&b)[16]) {
#pragma unroll
    for (int i = 0; i < 16; ++i) { const int x = a[i], y = b[15 - i]; a[i] = x > y ? x : y; }
    bitonic_merge_desc16(a);
}
__device__ __forceinline__ void merge_partner(int (&a)[16], int hi) {
    int b[16];
#pragma unroll
    for (int i = 0; i < 16; ++i) { auto rr = __builtin_amdgcn_permlane32_swap((unsigned)a[i], (unsigned)a[i], false, false); b[i] = (int)(hi ? rr[0] : rr[1]); }
    merge_top16(a, b);
}
#define RT_CAND_LIST(X) X(0,0,0) X(1,0,1) X(2,0,2) X(3,0,3) X(4,0,4) X(5,0,5) X(6,0,6) X(7,0,7) X(8,0,8) X(9,0,9) X(10,0,10) X(11,0,11) X(12,0,12) X(13,0,13) X(14,0,14) X(15,0,15) X(16,1,0) X(17,1,1) X(18,1,2) X(19,1,3) X(20,1,4) X(21,1,5) X(22,1,6) X(23,1,7) X(24,2,0) X(25,2,1) X(26,2,2) X(27,2,3) X(28,2,4) X(29,3,0) X(30,3,1) X(31,3,2) X(32,3,3) X(33,4,0) X(34,4,1) X(35,4,2) X(36,5,0) X(37,5,1) X(38,6,0) X(39,6,1) X(40,7,0) X(41,7,1) X(42,8,0) X(43,9,0) X(44,10,0) X(45,11,0) X(46,12,0) X(47,13,0) X(48,14,0) X(49,15,0)

__device__ __forceinline__ void route_item(const bf16_t* PQ, const bf16_t* SUBK  , int t0, int h, int* IDX, float* GATE, LAS int* lds_w) {
    const int lane = otid() & 63, r32 = lane & 31, hi = lane >> 5;
    int top[2][16];
#pragma unroll
    for (int p = 0; p < 2; ++p) {
        bf16x8 bq[8];
        { const bf16_t* qp = PQ + ((size_t)(((t0 >> 5) * 8 + h) * 2 + p) << 12) + (size_t)lane * 8;
          typedef __attribute__((address_space(1))) const bf16x8* gfrag_t;
          gfrag_t qg = (gfrag_t)qp; asm volatile("" : "+v"(qg));
#pragma unroll
          for (int ks = 0; ks < 8; ++ks) bq[ks] = qg[ks * 64]; }
        int cur[16];
#pragma unroll
        for (int kb = 0; kb < 4; ++kb) { f32x16 acc = f32x16{};
            const bf16_t* kp = SUBK + (size_t)(h * 2 + p) * 16384 + (size_t)(kb * 8 * 64 + lane) * 8;
            typedef __attribute__((address_space(1))) const bf16x8* gfrag_t;
            gfrag_t kg_ = (gfrag_t)kp; asm volatile("" : "+v"(kg_));
            bf16x8 af[8];
#pragma unroll
            for (int ks = 0; ks < 8; ++ks) af[ks] = kg_[ks * 64];
#pragma unroll
            for (int ks = 0; ks < 8; ++ks) acc = __builtin_amdgcn_mfma_f32_32x32x16_bf16(af[ks], bq[ks], acc, 0, 0, 0);
            int v[16];
#pragma unroll
            for (int r = 0; r < 16; ++r) { const int key = kb * 32 + (r & 3) + 8 * (r >> 2) + 4 * hi; v[r] = (f2key(acc[r]) & ~0x7F) | key; }
            sort_desc<16>(v);
            if (kb == 0) {
#pragma unroll
                for (int r = 0; r < 16; ++r) cur[r] = v[r]; }
            else merge_top16(cur, v);
            __builtin_amdgcn_sched_barrier(0); }
        merge_partner(cur, hi);
#pragma unroll
        for (int r = 0; r < 16; ++r) top[p][r] = cur[r];
    }
    float sa[16], sb[16];
#pragma unroll
    for (int r = 0; r < 16; ++r) { sa[r] = key2f(top[0][r] & ~0x7F); sb[r] = key2f(top[1][r] & ~0x7F); }
    int best[16];
    { int cv[64];
#pragma unroll
      for (int n = 50; n < 64; ++n) cv[n] = (int)0x80000000;
#define RT_CX(n, i, j) cv[n] = (f2key(sa[i] + sb[j]) & ~0xFF) | ((i) * 16 + (j));
      RT_CAND_LIST(RT_CX)
#undef RT_CX
#pragma unroll
      for (int gI = 0; gI < 4; ++gI) { int v[16];
#pragma unroll
          for (int r = 0; r < 16; ++r) v[r] = cv[gI * 16 + r];
          sort_desc<16>(v);
          if (gI == 0) {
#pragma unroll
              for (int r = 0; r < 16; ++r) best[r] = v[r]; }
          else merge_top16(best, v); } }
#pragma unroll
    for (int r = 0; r < 16; ++r) { lds_w[r * 64 + lane] = top[0][r]; lds_w[(16 + r) * 64 + lane] = top[1][r]; }
    asm volatile("s_waitcnt lgkmcnt(0)" ::: "memory");
    int eidx[16]; float sc[16]; float mx = -1e30f;
#pragma unroll
    for (int k = 0; k < 16; ++k) { const int code = best[k] & 0xFF; const int a = lds_w[(code >> 4) * 64 + lane], b = lds_w[(16 + (code & 15)) * 64 + lane];
        eidx[k] = (a & 0x7F) * 128 + (b & 0x7F); sc[k] = key2f(a & ~0x7F) + key2f(b & ~0x7F); mx = fmaxf(mx, sc[k]); }
    float sum = 0.f;
#pragma unroll
    for (int k = 0; k < 16; ++k) { sc[k] = __expf(sc[k] - mx); sum += sc[k]; }
    const float inv = 1.f / sum;
    asm volatile("s_waitcnt lgkmcnt(0)" ::: "memory");
    const size_t off = (size_t)(t0 + r32) * 128 + h * 16;
    unsigned* dst = hi ? (unsigned*)(GATE + off) : (unsigned*)(IDX + off);
#pragma unroll
    for (int q = 0; q < 4; ++q) { u32x4 w;
        w.x = hi ? __float_as_uint(sc[q * 4 + 0] * inv) : (unsigned)eidx[q * 4 + 0]; w.y = hi ? __float_as_uint(sc[q * 4 + 1] * inv) : (unsigned)eidx[q * 4 + 1];
        w.z = hi ? __float_as_uint(sc[q * 4 + 2] * inv) : (unsigned)eidx[q * 4 + 2]; w.w = hi ? __float_as_uint(sc[q * 4 + 3] * inv) : (unsigned)eidx[q * 4 + 3];
        *(u32x4*)(dst + q * 4) = w; }
}
}
__device__ __forceinline__ void route_phase(const bf16_t* PQ, const bf16_t* SUBK, int* IDX, float* GATE, LAS unsigned char* lds) {
    const int wid = otid() >> 6, gw = obid() * 8 + wid, nw = gridDim.x * 8;
    LAS int* lw = (LAS int*)(lds + wid * 8192);
    for (int it = gw; it < (T / 32) * PEER_H; it += nw) { const int tt = it >> 3, h = it & 7; rt::route_item(PQ, SUBK, tt * 32, h, IDX, GATE, lw); }
}

__device__ __forceinline__ float gelu_erf(float x) { return 0.5f * x * (1.f + erff(x * 0.70710678118654752f)); }
#define PE_POS(j) ((((j) & 7) << 4) | ((j) >> 3))
constexpr int PE_OFFP = 132, PE_ACTP = 132;
constexpr int PE_VB_PITCH = 136, PE_VB_BYTES = 64 * PE_VB_PITCH;
static_assert(64 * 132 * 4 + 2 * 64 * 128 + 256 + 8 * PE_VB_BYTES + 8 * 1024 <= 128 * 1024, "expert phase LDS");
constexpr int PE_OFF_BYTES = 64 * PE_OFFP * 4, PE_ACT_BYTES = 64 * PE_ACTP * 4;
__device__ __forceinline__ float dot_fp8x4(unsigned w, unsigned xa, unsigned xb, float s) {
    const bf16x2_t q0 = __builtin_amdgcn_cvt_scalef32_pk_bf16_fp8(w, 1.0f, false), q1 = __builtin_amdgcn_cvt_scalef32_pk_bf16_fp8(w, 1.0f, true);
    s = __builtin_amdgcn_fdot2_f32_bf16(q0, __builtin_bit_cast(bf16x2_t, xa), s, false); return __builtin_amdgcn_fdot2_f32_bf16(q1, __builtin_bit_cast(bf16x2_t, xb), s, false);
}
__device__ __forceinline__ void peer_phase(const unsigned char* H8, const int* IDX, const float* GATE, const unsigned char* U, const unsigned char* V, const float* usc, const float* vsc,
                                           const float* xin  , const float* gate2, float* out, int out_b16  , LAS unsigned char* lds) {
    const int tid = otid(), lane = tid & 63, wid = tid >> 6, g = lane >> 3, l8 = lane & 7, tw = wid * 8 + g;
    LAS unsigned* offl = (LAS unsigned*)lds; LAS unsigned char* a8hi = lds + PE_OFF_BYTES; LAS unsigned char* a8lo = a8hi + 64 * 128; LAS float* tscl = (LAS float*)(a8lo + 64 * 128);
    LAS unsigned char* vbw = lds + PE_OFF_BYTES + 2 * 64 * 128 + 256 + wid * PE_VB_BYTES; LAS float* actw = (LAS float*)vbw;
    const LAS u32x4* offrow = (const LAS u32x4*)(offl + tw * PE_OFFP);
    const unsigned lpart = (unsigned)l8 * 16u;
    for (int tile = obid(); tile < T / 64; tile += gridDim.x) {
        const int t0 = tile * 64, t = t0 + tw, b = t >> 13;
        __syncthreads();
        { int iv[16];
#pragma unroll
          for (int q = 0; q < 16; ++q) iv[q] = IDX[(size_t)t0 * 128 + tid + 512 * q];
          const int tp_ = otid();
#pragma unroll
          for (int q = 0; q < 16; ++q) { const int i = tp_ + 512 * q; offl[(i >> 7) * PE_OFFP + PE_POS(i & 127)] = ((unsigned)iv[q]) << 7; } }
        __syncthreads();
        {
            const int lane = otid() & 63;
            const int m16 = lane & 15, kg = lane >> 4;
            const unsigned lpu = (unsigned)((lane & 7) * 16);
            const int bidx = 4 * (8 * (m16 >> 1) + (m16 & 1) + 2 * kg);
            f32x4 acc[8][2];
#pragma unroll
            for (int a_ = 0; a_ < 8; ++a_) { acc[a_][0] = f32x4{0.f, 0.f, 0.f, 0.f}; acc[a_][1] = f32x4{0.f, 0.f, 0.f, 0.f}; }
            const unsigned char* hrow = H8 + (size_t)(t0 + wid * 8) * DM + 64 * (kg >> 1) + 16 * (kg & 1) + 32 * (m16 & 1);
            const LAS u32x4* offw = (const LAS u32x4*)(offl + (wid * 8) * PE_OFFP + (lane >> 3) * 16);
            const int mq = m16 >> 1;
            u32x4 buf[16]; u32x4 hA, hB;
            { const LAS u32x4* offc = offw; asm volatile("" : "+v"(offc));
              const u32x4 o0 = offc[0], o1 = offc[1], o2 = offc[2], o3 = offc[3];
              hA = *(const u32x4*)(hrow); hB = *(const u32x4*)(hrow + 128);
              __builtin_amdgcn_sched_barrier(0);
#define PE_UL(g, ov) buf[g] = *(const u32x4*)((const char*)U + (size_t)((ov) + lpu));
              PE_UL(0, o0.x) PE_UL(8, o2.x) PE_UL(1, o0.y) PE_UL(9, o2.y) PE_UL(2, o0.z) PE_UL(10, o2.z) PE_UL(3, o0.w) PE_UL(11, o2.w)
              PE_UL(4, o1.x) PE_UL(12, o3.x) PE_UL(5, o1.y) PE_UL(13, o3.y) PE_UL(6, o1.z) PE_UL(14, o3.z) PE_UL(7, o1.w) PE_UL(15, o3.w)
#undef PE_UL
              __builtin_amdgcn_sched_barrier(0); }
#define PE_PERM(dst, src) { const u32x4 s_ = (src); (dst).x = (unsigned)__builtin_amdgcn_ds_bpermute(bidx, (int)s_.x); (dst).y = (unsigned)__builtin_amdgcn_ds_bpermute(bidx, (int)s_.y); (dst).z = (unsigned)__builtin_amdgcn_ds_bpermute(bidx, (int)s_.z); (dst).w = (unsigned)__builtin_amdgcn_ds_bpermute(bidx, (int)s_.w); }
            u32x4 tq[4]; PE_PERM(tq[0], buf[0]) PE_PERM(tq[1], buf[8])
#pragma unroll 1
            for (int c = 0; c < 8; ++c) {
                const char* ub = (const char*)(U + (size_t)c * PEER_E * 128);
                const int cn = c + 1 < 8 ? c + 1 : c;
                const char* ubn = (const char*)(U + (size_t)cn * PEER_E * 128);
#pragma unroll
                for (int tk = 0; tk < 8; ++tk) {
                    const int tkn = (tk + 1) & 7; const char* nb_ = tk == 7 ? ubn : ub; const int ccn = tk == 7 ? cn : c;
                    const LAS u32x4* offc = offw + tkn * (PE_OFFP / 4); asm volatile("" : "+v"(offc));
                    const u32x4 o0 = offc[0], o1 = offc[1], o2 = offc[2], o3 = offc[3];
                    const unsigned char* hn = hrow + (size_t)tkn * DM + ccn * 256;
                    const u32x4 hnA = *(const u32x4*)(hn), hnB = *(const u32x4*)(hn + 128);
                    __builtin_amdgcn_sched_barrier(0);
#define PE_UM(q, sft, ovA, ovB) { const bool sel = mq == (q); pg8::i32x8 hv; \
                        hv[0] = sel ? (int)hA.x : 0; hv[1] = sel ? (int)hA.y : 0; hv[2] = sel ? (int)hA.z : 0; hv[3] = sel ? (int)hA.w : 0; hv[4] = sel ? (int)hB.x : 0; hv[5] = sel ? (int)hB.y : 0; hv[6] = sel ? (int)hB.z : 0; hv[7] = sel ? (int)hB.w : 0; \
                        { PE_PERM(tq[(2 * (q) + 2) & 3], buf[((q) + 1) & 7]) const u32x4 t_ = tq[(2 * (q)) & 3]; const pg8::i32x8 rv = {(int)t_.x, (int)t_.y, (int)t_.z, (int)t_.w, 0, 0, 0, 0}; \
                          acc[tk][0] = __builtin_amdgcn_mfma_scale_f32_16x16x128_f8f6f4(hv, rv, acc[tk][0], 0, 4, 0, 0x7F7F7F7F, 0, 0x7F7F7F7F); buf[q] = *(const u32x4*)(nb_ + (size_t)((ovA) + lpu)); } \
                        __builtin_amdgcn_sched_barrier(0); \
                        { PE_PERM(tq[(2 * (q) + 3) & 3], buf[8 + (((q) + 1) & 7)]) const u32x4 t_ = tq[(2 * (q) + 1) & 3]; const pg8::i32x8 rv = {(int)t_.x, (int)t_.y, (int)t_.z, (int)t_.w, 0, 0, 0, 0}; \
                          acc[tk][1] = __builtin_amdgcn_mfma_scale_f32_16x16x128_f8f6f4(hv, rv, acc[tk][1], 0, 4, 0, 0x7F7F7F7F, 0, 0x7F7F7F7F); buf[8 + (q)] = *(const u32x4*)(nb_ + (size_t)((ovB) + lpu)); } \
                        __builtin_amdgcn_sched_barrier(0); }
                    PE_UM(0, 0, o0.x, o2.x) PE_UM(1, 0, o0.y, o2.y) PE_UM(2, 0, o0.z, o2.z) PE_UM(3, 0, o0.w, o2.w) PE_UM(4, 0, o1.x, o3.x) PE_UM(5, 0, o1.y, o3.y) PE_UM(6, 0, o1.z, o3.z) PE_UM(7, 0, o1.w, o3.w)
#undef PE_UM
                    hA = hnA; hB = hnB;
                }
            }
#undef PE_PERM
#pragma unroll
            for (int tk = 0; tk < 8; ++tk)
#pragma unroll
                for (int hs = 0; hs < 2; ++hs) { const f32x4 a_ = acc[tk][hs];
                    const float v0 = a_[0] + __shfl_xor(a_[1], 1), v1 = a_[2] + __shfl_xor(a_[3], 1);
                    if ((m16 & 1) == 0) { LAS float* ap = actw + tk * PE_ACTP + (m16 >> 1) * 16 + hs * 8 + 2 * kg; ap[0] = v0; ap[1] = v1; } }
        }
        {
            const int lane = otid() & 63;
            float gt[8][2], su[8][2], sv[8][2];
#pragma unroll
            for (int tk = 0; tk < 8; ++tk)
#pragma unroll
                for (int hf = 0; hf < 2; ++hf) { const int j = lane + 64 * hf; const unsigned ex = offl[(wid * 8 + tk) * PE_OFFP + PE_POS(j)] >> 7;
                    gt[tk][hf] = GATE[(size_t)(t0 + wid * 8 + tk) * 128 + j]; { typedef float f32x2_t __attribute__((ext_vector_type(2))); const f32x2_t s2_ = *(const f32x2_t*)(usc + 2 * (size_t)ex); su[tk][hf] = s2_[0]; sv[tk][hf] = s2_[1]; } }
            const int kr = (lane & 0x30) == 0x10 ? lane + 16 : ((lane & 0x30) == 0x20 ? lane - 16 : lane);
#pragma unroll
            for (int tk = 0; tk < 8; ++tk) { float av[2]; float mx = 0.f;
#pragma unroll
                for (int hf = 0; hf < 2; ++hf) { const int j = lane + 64 * hf; av[hf] = gelu_erf(actw[tk * PE_ACTP + PE_POS(j)] * su[tk][hf]) * gt[tk][hf] * sv[tk][hf]; mx = fmaxf(mx, fabsf(av[hf])); }
#pragma unroll
                for (int o = 32; o >= 1; o >>= 1) mx = fmaxf(mx, __shfl_xor(mx, o));
                const int exm = (int)((__float_as_uint(mx) >> 23) & 0xff);
                int se = 261 - exm; se = se < 1 ? 1 : (se > 254 ? 254 : se);
                const float sc_ = exm == 0 ? 1.f : __uint_as_float((unsigned)se << 23);
                if (lane == 0) tscl[wid * 8 + tk] = 1.f / sc_;
#pragma unroll
                for (int hf = 0; hf < 2; ++hf) { const float x_ = av[hf] * sc_;
                    const int ph = __builtin_amdgcn_cvt_pk_fp8_f32(x_, 0.f, 0, false); const float hif = __builtin_amdgcn_cvt_f32_fp8(ph, 0);
                    const int pl = __builtin_amdgcn_cvt_pk_fp8_f32(x_ - hif, 0.f, 0, false);
                    a8hi[(wid * 8 + tk) * 128 + hf * 64 + kr] = (unsigned char)(ph & 0xff); a8lo[(wid * 8 + tk) * 128 + hf * 64 + kr] = (unsigned char)(pl & 0xff); } }
        }
        {
            const int lane = otid() & 63;
            const int q16 = lane & 15, kg = lane >> 4, kgm = kg & 1, r8 = lane >> 3, p8 = lane & 7;
            const LAS unsigned char* tr1 = vbw + (16 * kgm + q16) * PE_VB_PITCH + 32 * (kg >> 1); const LAS unsigned char* tr2 = tr1 + 32 * PE_VB_PITCH;
            LAS unsigned char* wr = vbw + r8 * PE_VB_PITCH + p8 * 16;
            const LAS u32x4* offw = (const LAS u32x4*)(offl + (wid * 8) * PE_OFFP + r8 * 16);
            const unsigned lpv = (unsigned)(p8 * 16);
            const int vsel = q16 >> 2, vhl = q16 & 3;
            const LAS unsigned char* a8p = ((vhl & 1) == 0 ? a8hi : a8lo) + (wid * 8) * 128 + 16 * kg;
            typedef int i32x2_t __attribute__((ext_vector_type(2)));
            LAS float* ystg = (LAS float*)(lds + PE_OFF_BYTES + 2 * 64 * 128 + 256 + 8 * PE_VB_BYTES + wid * 1024);
            u32x4 buf[16];
            { const LAS u32x4* offc = offw; asm volatile("" : "+v"(offc)); const u32x4 o0 = offc[0], o1 = offc[1], o2 = offc[2], o3 = offc[3];
#define PE_VL(g, ov, base_) buf[g] = *(const u32x4*)((base_) + (size_t)((ov) + lpv));
              PE_VL(0, o0.x, (const char*)V) PE_VL(1, o0.y, (const char*)V) PE_VL(2, o0.z, (const char*)V) PE_VL(3, o0.w, (const char*)V) PE_VL(4, o1.x, (const char*)V) PE_VL(5, o1.y, (const char*)V) PE_VL(6, o1.z, (const char*)V) PE_VL(7, o1.w, (const char*)V)
              PE_VL(8, o2.x, (const char*)V) PE_VL(9, o2.y, (const char*)V) PE_VL(10, o2.z, (const char*)V) PE_VL(11, o2.w, (const char*)V) PE_VL(12, o3.x, (const char*)V) PE_VL(13, o3.y, (const char*)V) PE_VL(14, o3.z, (const char*)V) PE_VL(15, o3.w, (const char*)V)
              __builtin_amdgcn_sched_barrier(0); }
#pragma unroll 1
            for (int c = 0; c < 8; ++c) {
                const char* vb_ = (const char*)(V + (size_t)c * PEER_E * 128);
                const int cn = c + 1 < 8 ? c + 1 : c;
                const char* vbn = (const char*)(V + (size_t)cn * PEER_E * 128);
                const f32x4 gr = *(const f32x4*)(gate2 + (size_t)(t0 >> 13) * 6 * DM + c * 256 + 4 * lane);
#pragma unroll 1
                for (int tk = 0; tk < 8; ++tk) {
                    const int tkn = (tk + 1) & 7; const char* nb_ = tk == 7 ? vbn : vb_;
                    const LAS u32x4* offc = offw + tkn * (PE_OFFP / 4); asm volatile("" : "+v"(offc));
                    const int tt = t0 + wid * 8 + tk; const int colb = c * 256 + 16 * kg + q16;
                    const u32x2 xw = *(const u32x2*)((const bf16_t*)xin + (size_t)tt * DM + c * 256 + 4 * lane);
                    const float tsc = tscl[wid * 8 + tk];
                    f32x4 acc[2];
#pragma unroll
                    for (int bq = 0; bq < 2; ++bq) acc[bq] = f32x4{0.f, 0.f, 0.f, 0.f};
#pragma unroll
                    for (int hu = 0; hu < 2; ++hu) {
                        const u32x4 on0 = offc[2 * hu], on1 = offc[2 * hu + 1];
#pragma unroll
                        for (int g8 = 0; g8 < 8; ++g8) { const u32x4 d_ = buf[hu * 8 + g8]; *(LAS u32x2*)(wr + g8 * 8 * PE_VB_PITCH) = u32x2{d_.x, d_.y}; *(LAS u32x2*)(wr + g8 * 8 * PE_VB_PITCH + 8) = u32x2{d_.z, d_.w}; }
                        { const unsigned ov[8] = {on0.x, on0.y, on0.z, on0.w, on1.x, on1.y, on1.z, on1.w};
#pragma unroll
                          for (int g8 = 0; g8 < 8; ++g8) buf[hu * 8 + g8] = *(const u32x4*)(nb_ + (size_t)(ov[g8] + lpv)); }
                        const u32x4 araw = *(const LAS u32x4*)(a8p + tk * 128 + hu * 64);
                        __builtin_amdgcn_sched_barrier(0);
                        i32x2_t ta[4], tb[4];
#define PE_TR(st) { const int nb_k = 8 * ((st) & 1) + ((st) >> 1); ta[(st) & 3] = __builtin_amdgcn_ds_read_tr4_b64_v2i32((LAS i32x2_t*)(tr1 + 8 * nb_k)); tb[(st) & 3] = __builtin_amdgcn_ds_read_tr4_b64_v2i32((LAS i32x2_t*)(tr2 + 8 * nb_k)); }
                        PE_TR(0) PE_TR(1) PE_TR(2)
#pragma unroll
                        for (int st = 0; st < 8; ++st) { const int vr = st >> 1, bq = st & 1; const bool s0 = (vsel == vr) && (vhl < 2), s1 = (vsel == vr) && (vhl >= 2);
                            const pg8::i32x8 hv = {s0 ? (int)araw.x : 0, s0 ? (int)araw.y : 0, s0 ? (int)araw.z : 0, s0 ? (int)araw.w : 0, s1 ? (int)araw.x : 0, s1 ? (int)araw.y : 0, s1 ? (int)araw.z : 0, s1 ? (int)araw.w : 0};
                            if (st + 3 < 8) PE_TR(st + 3)
                            const pg8::i32x8 rv = {ta[st & 3].x, ta[st & 3].y, tb[st & 3].x, tb[st & 3].y, 0, 0, 0, 0};
                            acc[bq] = __builtin_amdgcn_mfma_scale_f32_16x16x128_f8f6f4(hv, rv, acc[bq], 0, 4, 0, 0x7F7F7F7F, 0, 0x7F7F7F7F);
                            __builtin_amdgcn_sched_barrier(0); }
#undef PE_TR
                        __builtin_amdgcn_sched_barrier(0);
                    }
#pragma unroll
                    for (int bq = 0; bq < 2; ++bq)
#pragma unroll
                        for (int sb = 0; sb < 2; ++sb) ystg[128 * bq + 64 * sb + 16 * kg + q16] = (acc[bq][2 * sb] + acc[bq][2 * sb + 1]) * tsc;
                    { const f32x4 yv = *(const LAS f32x4*)(ystg + 4 * lane); const f32x4 xr = {bflo(xw.x), bfhi(xw.x), bflo(xw.y), bfhi(xw.y)}; const f32x4 o_ = xr + gr * yv; const size_t oi = (size_t)tt * DM + c * 256 + 4 * lane;
                      if (out_b16) *(u32x2*)((bf16_t*)out + oi) = u32x2{cvt_pk_bf16(o_[0], o_[1]), cvt_pk_bf16(o_[2], o_[3])}; else *(f32x4*)(out + oi) = o_; }
                }
            }
#undef PE_VL
        }
#undef PE_ISSUE
    }
}

constexpr int NPL = 13, NPH = 1 + DEPTH * NPL;
__host__ __device__ constexpr bool phase_exists(int ph) { if (ph == 0) return true; const int k = (ph - 1) % NPL, layer = (ph - 1) / NPL; return ((layer & 1) == 0) ? !(k == 6 || k == 7) : !(k == 2 || k == 5); }
__global__ void __launch_bounds__(512, 2) fwd_kernel(Args A) {
    extern __shared__ __attribute__((aligned(16))) unsigned char lds_raw[];
    LAS unsigned char* lds = (LAS unsigned char*)lds_raw;
    unsigned char* ws_ = A.ws;
#define WSB ow(ws_)
    const int G = gridDim.x, bid = blockIdx.x;
    volatile LAS unsigned* misc = (volatile LAS unsigned*)(lds + LDS_MAIN);
    if (threadIdx.x < 4) misc[threadIdx.x] = 0u;
    __syncthreads();
    XcdBarrier bar; bar.bar = (unsigned*)(WSB + WS_CTL); bar.x = 0; bar.st = misc;
    const bool fused = (A.ph_hi - A.ph_lo) > 1;
    if (fused) bar = xcd_barrier_post((unsigned*)(WSB + WS_CTL), misc);
    const float* MOD = (const float*)(WSB + WS_CTL + CTL_MOD_OFF);
#define HB ((bf16_t*)(WSB + WS_HB))
#define XA ((float*)(WSB + WS_XA))
#define XB ((float*)(WSB + WS_XB))
    bf16_t* OB = (bf16_t*)A.out;
#define PQ ((bf16_t*)(WSB + WS_PQ))
#define IDX ((int*)(WSB + WS_IDX))
#define GATE ((float*)(WSB + WS_GATE))
#define R1 (WSB + WS_R1)
#define IN(k) (A.ph_lo <= (k) && (k) < A.ph_hi)
#define SEAM(k) do { if ((k) + 1 < A.ph_hi) xcd_barrier(bar); } while (0)
#define REPS(bit) for (int rp_ = 0; rp_ < ((((REP_MASK) >> (bit)) & 1) ? 2 : 1); ++rp_)
#define REPB(bit) do { if ((((REP_MASK) >> (bit)) & 1) && fused) xcd_barrier(bar); } while (0)
    if (IN(0)) { REPS(0) { prologue_phase(A, lds); REPB(0); } SEAM(0); }
#pragma unroll 1
    for (int layer = 0; layer < DEPTH; ++layer) {
        const int pb = 1 + layer * NPL;
        const float* modl = MOD + (size_t)layer * 2 * 6 * DM;
        const float* xcur = layer == 0 ? A.x : XB;
        float* xout = layer == DEPTH - 1 ? A.out : XB;
        const bool mla = (layer & 1) == 0;
        if (IN(pb + 0)) { REPS(1) { norm_phase(xcur, A.norm_g + (size_t)(layer * 2 + 0) * DM, modl, 0, DM, HB, 1, nullptr, layer > 0); REPB(1); } SEAM(pb + 0); }
        const int nsub = mla ? 1 : 2;
#pragma unroll 1
        for (int sb = 0; sb < nsub; ++sb) {
            if (IN(pb + 1 + 3 * sb)) {
                pg8::Gemm g; pg8::EpiBf16 E;
                if (mla) { g = pg8::Gemm{HB, (const bf16_t*)(WSB + WS_WIN_MLA), T, MLA_IN_PAD, DM / 2}; E = pg8::EpiBf16{(bf16_t*)(R1 + R1_Z), MLA_IN_PAD, 0, nullptr, nullptr, nullptr, nullptr, nullptr, 1.f / DIL_WSCALE, nullptr}; }
                else { const unsigned* csT = (const unsigned*)(WSB + WS_ROPE) + (size_t)sb * SEQ * 64;
                       g = pg8::Gemm{(const bf16_t*)((const unsigned char*)HB + (size_t)sb * SEQ * DM), (const bf16_t*)(WSB + WS_WIN_DIL), SEQ, DIL_IN, DM / 2};
                       E = pg8::EpiBf16{(bf16_t*)(R1 + R1_ZD), DIL_IN, 1, csT, nullptr, A.dil_g_qn, A.dil_g_kn, (LAS float*)(lds + LDS_XCH), 1.f / DIL_WSCALE, nullptr}; }
                pg8::StaticOrder S; S.init(g.M, g.N, G, bid);
                REPS(2) { pg8::gemm_phase<pg8::EpiBf16, pg8::StaticOrder, true>(lds, g, S, E); REPB(2); }
                SEAM(pb + 1 + 3 * sb);
            }
            if (mla && IN(pb + 2)) {
                REPS(3) { mla_cnorm_phase((const bf16_t*)(R1 + R1_Z), A.mla_g_q, A.mla_g_kv, R1 + R1_CQN, R1 + R1_CKVN); REPB(3); }
                SEAM(pb + 2);
            }
            if (mla) {
                if (IN(pb + 3)) {
                    REPS(4) {
#pragma unroll 1
                    for (int w = 0; w < 2; ++w) {
                        pg8::Gemm g = w == 0 ? pg8::Gemm{(const bf16_t*)(R1 + R1_CQN), (const bf16_t*)(WSB + WS_WUQ), T, 3072, 256} : pg8::Gemm{(const bf16_t*)(R1 + R1_CKVN), (const bf16_t*)(WSB + WS_WUKV), T, 4096, 256};
                        pg8::EpiBf16 E = w == 0 ? pg8::EpiBf16{(bf16_t*)(WSB + WS_QRAW), 3072, 0, nullptr, nullptr, nullptr, nullptr, nullptr, 1.f / DIL_WSCALE, nullptr} : pg8::EpiBf16{(bf16_t*)(WSB + WS_KVRAW), 4096, 0, nullptr, nullptr, nullptr, nullptr, nullptr, 1.f / DIL_WSCALE, (bf16_t*)(R1 + R1_V)};
                        pg8::StaticOrder S; S.init(g.M, g.N, G, bid);
                        pg8::gemm_phase<pg8::EpiBf16, pg8::StaticOrder, true>(lds, g, S, E);
                    }
                    REPB(4); }
                    SEAM(pb + 3);
                }
                if (IN(pb + 4)) {
                    REPS(5) { mla_qkv_phase((const bf16_t*)(WSB + WS_QRAW), (const bf16_t*)(WSB + WS_KVRAW), (const bf16_t*)(R1 + R1_Z), A.pos, A.mla_g_qn, A.mla_g_kn, (bf16_t*)(R1 + R1_Q), (bf16_t*)(R1 + R1_K)); REPB(5); }
                    SEAM(pb + 4);
                }
                if (IN(pb + 5)) {
                    const bf16_t* Qb = (const bf16_t*)(R1 + R1_Q); const bf16_t* Kb = (const bf16_t*)(R1 + R1_K); const bf16_t* Vb = (const bf16_t*)(R1 + R1_V);
                    REPS(6) {
                    for (int x = bid; x < 512; x += G) {
                        const int xl = x & 255, xcd = xl & 7, idx = xl >> 3; const int bh = (x >> 8) * 16 + xcd * 2 + (idx >> 4), y = idx & 15, b = bh >> 4, h = bh & 15;
#pragma unroll 1
                        for (int pass = 0; pass < 2; ++pass) {
                            const int qb = pass == 0 ? 31 - y : y;
                            at::Item it; it.Q = Qb + (size_t)bh * SEQ * 192; it.K = Kb + (size_t)bh * SEQ * 192; it.V = Vb + (size_t)bh * SEQ * 128;
                            it.O = (bf16_t*)((unsigned char*)OB + (size_t)b * SEQ * DM + h * 128); it.o_f8 = 1; it.LSE = nullptr; it.qs = 192; it.ks = 192; it.vs = 128; it.os = DM; it.ls = 0; it.i0 = qb * 256; it.W = 1 << 30; it.L = SEQ;
                            at::attn_block<192>(it, (LAS char*)lds);
                        }
                    }
                    REPB(6); }
                    SEAM(pb + 5);
                }
            } else {
                if (IN(pb + 3 + 3 * sb)) {
                    bf16_t* ZD = (bf16_t*)(R1 + R1_ZD); bf16_t* OG = (bf16_t*)(WSB + WS_OG); float* LSE = (float*)(WSB + WS_LSE);
                    REPS(7) {
                    for (int id = bid; id < 1536; id += G) {
                        const int g = id >> 9, rem = id & 511; const int dsh = 2 * g, dil = 1 << dsh, L = SEQ >> dsh, nqb = L >> 8;
                        const int qb = rem % nqb, r2 = rem / nqb, h = r2 & 15, r = r2 >> 4;
                        at::Item it; const size_t tok0 = (size_t)sb * SEQ + r;
                        const bf16_t* zb = ZD + ((size_t)(g * 3 * 16 + h) * SEQ + (size_t)r * L) * 128;
                        it.Q = zb; it.K = zb + (size_t)16 * SEQ * 128; it.V = zb + (size_t)32 * SEQ * 128; it.qs = it.ks = it.vs = 128;
                        it.O = OG + ((size_t)g * T + tok0) * DM + h * 128; it.os = (long)dil * DM; it.LSE = LSE + ((size_t)g * T + tok0) * 16 + h; it.ls = (long)dil * 16;
                        it.i0 = qb * 256; it.W = 129; it.L = L; it.o_f8 = 0;
                        at::attn_block<128>(it, (LAS char*)lds);
                    }
                    REPB(7); }
                    SEAM(pb + 3 + 3 * sb);
                }
            }
        }
        if (!mla && IN(pb + 7)) { REPS(8) { dil_combine_phase((const bf16_t*)(WSB + WS_OG), (const float*)(WSB + WS_LSE), OB); REPB(8); } SEAM(pb + 7); }
        if (IN(pb + 8)) {
            pg8::Gemm g{OB, (const bf16_t*)(WSB + (mla ? WS_WO_MLA : WS_WO_DIL)), T, DM, DM / 2};
            pg8::EpiResGate E{xcur, modl + 2 * DM, 6 * DM, (bf16_t*)XA, DM, 1.f / (ACT_F8SCALE * DIL_WSCALE), layer > 0};
            pg8::StaticOrder S; S.init(g.M, g.N, G, bid);
            REPS(9) { pg8::gemm_phase<pg8::EpiResGate, pg8::StaticOrder, true>(lds, g, S, E); REPB(9); }
            SEAM(pb + 8);
        }
        if (IN(pb + 9)) {
            REPS(10) { norm_phase(XA, A.norm_g + (size_t)(layer * 2 + 1) * DM, modl, 3 * DM, 4 * DM, HB, 0, R1  , 1);
            tables_phase(A.peer_u + (size_t)layer * PEER_E * DM, A.peer_v + (size_t)layer * PEER_E * DM, WSB + WS_UTAB, WSB + WS_VTAB, (float*)(WSB + WS_USC), (float*)(WSB + WS_USC) + 1); REPB(10); }
            SEAM(pb + 9);
        }
        if (IN(pb + 10)) {
            pg8::Gemm g{HB, (const bf16_t*)(WSB + WS_WQ) + (size_t)layer * DM * DM, T, DM, DM};
            pg8::EpiBf16 E{PQ, DM, 2, nullptr, nullptr, nullptr, nullptr, nullptr, 1.f, nullptr};
            pg8::StaticOrder S; S.init(g.M, g.N, G, bid);
            REPS(11) { pg8::gemm_phase<pg8::EpiBf16, pg8::StaticOrder>(lds, g, S, E); REPB(11); }
            SEAM(pb + 10);
        }
        if (IN(pb + 11)) { REPS(12) { route_phase(PQ, (const bf16_t*)(WSB + WS_SUBK) + (size_t)layer * 8 * 2 * 128 * 128, IDX, GATE, lds); REPB(12); } SEAM(pb + 11); }
        if (IN(pb + 12)) {
            REPS(13) { peer_phase(R1, IDX, GATE, WSB + WS_UTAB, WSB + WS_VTAB, (const float*)(WSB + WS_USC), (const float*)(WSB + WS_VSC), XA, modl + 5 * DM, xout, layer + 1 < DEPTH, lds); REPB(13); }
            SEAM(pb + 12);
        }
    }
#undef IN
#undef SEAM
#undef REPS
#undef REPB
}

#undef WSB
#undef HB
#undef XA
#undef XB
#undef PQ
#undef IDX
#undef GATE
#undef R1
extern "C" void kernel_launch(void* const* d_in, const int* in_sizes, int n_in, void* d_out, int out_size, void* d_ws, size_t ws_size, hipStream_t stream) {
    static int grid = 0;
    if (grid == 0) {
        if (n_in != 22 || out_size != T * DM || ws_size < WS_END) { fprintf(stderr, "kernel_launch: unexpected shapes (n_in %d out %d ws %zu need %zu)\n", n_in, out_size, ws_size, (size_t)WS_END); grid = -1; return; }
        int dev = 0, cus = 0, per_cu = 0;
        if (hipGetDevice(&dev) != hipSuccess || hipDeviceGetAttribute(&cus, hipDeviceAttributeMultiprocessorCount, dev) != hipSuccess) { grid = -1; return; }
        if (hipFuncSetAttribute((const void*)fwd_kernel, hipFuncAttributeMaxDynamicSharedMemorySize, LDS_BYTES) != hipSuccess) { fprintf(stderr, "kernel_launch: hipFuncSetAttribute failed\n"); grid = -1; return; }
        if (hipOccupancyMaxActiveBlocksPerMultiprocessor(&per_cu, (const void*)fwd_kernel, 512, LDS_BYTES) != hipSuccess || per_cu < 1) { fprintf(stderr, "kernel_launch: occupancy query says %d\n", per_cu); (void)hipGetLastError(); }
        grid = cus;
    }
    if (grid < 0) return;
    (void)hipMemsetAsync((char*)d_ws + WS_CTL, 0, CTL_BYTES, stream);
    Args a{};
    a.x = (const float*)d_in[0]; a.c = (const float*)d_in[1]; a.pos = (const int*)d_in[2]; a.ada_w = (const float*)d_in[3]; a.ada_b = (const float*)d_in[4]; a.norm_g = (const float*)d_in[5];
    a.mla_w_in = (const float*)d_in[6]; a.mla_g_q = (const float*)d_in[7]; a.mla_w_uq = (const float*)d_in[8]; a.mla_g_kv = (const float*)d_in[9]; a.mla_w_ukv = (const float*)d_in[10];
    a.mla_g_qn = (const float*)d_in[11]; a.mla_g_kn = (const float*)d_in[12]; a.mla_w_o = (const float*)d_in[13];
    a.dil_w_in = (const float*)d_in[14]; a.dil_g_qn = (const float*)d_in[15]; a.dil_g_kn = (const float*)d_in[16]; a.dil_w_o = (const float*)d_in[17];
    a.peer_w_q = (const float*)d_in[18]; a.peer_sub_keys = (const float*)d_in[19]; a.peer_u = (const float*)d_in[20]; a.peer_v = (const float*)d_in[21];
    a.out = (float*)d_out; a.ws = (unsigned char*)d_ws;
#if MK_ONE_LAUNCH
    a.ph_lo = 0; a.ph_hi = NPH;
    hipLaunchKernelGGL(fwd_kernel, dim3(grid), dim3(512), LDS_BYTES, stream, a);
#else
    for (int ph = 0; ph < NPH; ++ph) {
        if (!phase_exists(ph)) continue;
        a.ph_lo = ph; a.ph_hi = ph + 1;
        hipLaunchKernelGGL(fwd_kernel, dim3(grid), dim3(512), LDS_BYTES, stream, a);
    }
#endif
}

#ifdef PHASE_AUDIT
#define AUD_LDS extern __shared__ __attribute__((aligned(16))) unsigned char lds_raw[]; LAS unsigned char* lds = (LAS unsigned char*)lds_raw
__global__ void __launch_bounds__(512, 2) aud_prologue(Args A) { AUD_LDS; prologue_phase(A, lds); }
__global__ void __launch_bounds__(512, 2) aud_norm(Args A) { norm_phase(A.x, A.norm_g, A.ada_b, 0, DM, (bf16_t*)A.ws, A.ph_lo); }
__global__ void __launch_bounds__(512, 2) aud_gemm_bf16(Args A) { AUD_LDS; pg8::Gemm g{(const bf16_t*)A.ws, (const bf16_t*)A.ws + 1000000, T, A.ph_lo, A.ph_hi}; pg8::EpiBf16 E{(bf16_t*)A.out, A.ph_lo, A.ph_hi & 1, (const unsigned*)A.x, A.c, A.ada_b, A.norm_g, (LAS float*)(lds + LDS_XCH), 1.f, nullptr}; pg8::StaticOrder S; S.init(g.M, g.N, gridDim.x, blockIdx.x); pg8::gemm_phase<pg8::EpiBf16, pg8::StaticOrder>(lds, g, S, E); }
__global__ void __launch_bounds__(512, 2) aud_gemm_f8(Args A) { AUD_LDS; pg8::Gemm g{(const bf16_t*)A.ws, (const bf16_t*)A.ws + 1000000, T, A.ph_lo, A.ph_hi}; pg8::EpiBf16 E{(bf16_t*)A.out, A.ph_lo, A.ph_hi & 1, (const unsigned*)A.x, A.c, A.ada_b, A.norm_g, (LAS float*)(lds + LDS_XCH), 0.5f, nullptr}; pg8::StaticOrder S; S.init(g.M, g.N, gridDim.x, blockIdx.x); pg8::gemm_phase<pg8::EpiBf16, pg8::StaticOrder, true>(lds, g, S, E); }
__global__ void __launch_bounds__(512, 2) aud_gemm_res(Args A) { AUD_LDS; pg8::Gemm g{(const bf16_t*)A.ws, (const bf16_t*)A.ws + 1000000, T, A.ph_lo, A.ph_hi}; pg8::EpiResGate E{A.x, A.c, 6 * DM, (bf16_t*)A.out, DM, 0.5f, A.ph_lo}; pg8::StaticOrder S; S.init(g.M, g.N, gridDim.x, blockIdx.x); pg8::gemm_phase<pg8::EpiResGate, pg8::StaticOrder>(lds, g, S, E); }
__global__ void __launch_bounds__(512, 2) aud_cnorm(Args A) { mla_cnorm_phase((const bf16_t*)A.ws, A.mla_g_q, A.mla_g_kv, (unsigned char*)A.out, (unsigned char*)A.out + 100000); }
__global__ void __launch_bounds__(512, 2) aud_qkv(Args A) { mla_qkv_phase((const bf16_t*)A.ws, (const bf16_t*)A.ws + 1000, (const bf16_t*)A.ws + 2000, A.pos, A.mla_g_qn, A.mla_g_kn, (bf16_t*)A.out, (bf16_t*)A.out + 1000); }
__global__ void __launch_bounds__(512, 2) aud_comb(Args A) { dil_combine_phase((const bf16_t*)A.ws, A.x, (bf16_t*)A.out); }
__global__ void __launch_bounds__(512, 2) aud_attn192(Args A) { AUD_LDS; at::Item it; it.Q = (const bf16_t*)A.ws; it.K = it.Q + 1000; it.V = it.Q + 2000; it.O = (bf16_t*)A.out; it.LSE = nullptr; it.qs = 192; it.ks = 192; it.vs = 128; it.os = DM; it.ls = 0; it.i0 = A.ph_lo * 256; it.W = 1 << 30; it.L = SEQ; it.o_f8 = A.ph_hi & 1; at::attn_block<192>(it, (LAS char*)lds); }
__global__ void __launch_bounds__(512, 2) aud_attn128(Args A) { AUD_LDS; at::Item it; it.Q = (const bf16_t*)A.ws; it.K = it.Q + 1000; it.V = it.Q + 2000; it.O = (bf16_t*)A.out; it.LSE = (float*)A.out + 5000; it.qs = A.ph_hi; it.ks = A.ph_hi; it.vs = A.ph_hi; it.os = DM; it.ls = 16; it.i0 = A.ph_lo * 256; it.W = 129; it.L = SEQ; it.o_f8 = 0; at::attn_block<128>(it, (LAS char*)lds); }
__global__ void __launch_bounds__(512, 2) aud_route(Args A) { AUD_LDS; route_phase((const bf16_t*)A.ws, (const bf16_t*)A.ws + 100000, (int*)A.out, A.out + 100000, lds); }
__global__ void __launch_bounds__(512, 2) aud_peer(Args A) { AUD_LDS; peer_phase((const unsigned char*)A.ws, A.pos, A.x, A.ws + 1000, A.ws + 2000, A.c, A.c, A.c, A.ada_b, A.out, A.ph_lo, lds); }
#endif
```

```cpp
#include <hip/hip_runtime.h>
#include <stdint.h>
#include <stdio.h>

#ifndef MK_ONE_LAUNCH
#define MK_ONE_LAUNCH 1
#endif
#ifndef REP_MASK
#define REP_MASK 0
#endif

#define LAS __attribute__((address_space(3)))
typedef unsigned short bf16_t;
typedef short bf16x8 __attribute__((ext_vector_type(8)));
typedef short s16x4 __attribute__((ext_vector_type(4)));
typedef float f32x4 __attribute__((ext_vector_type(4)));
typedef float f32x2 __attribute__((ext_vector_type(2)));
typedef float f32x16 __attribute__((ext_vector_type(16)));
typedef unsigned u32x4 __attribute__((ext_vector_type(4)));
typedef unsigned u32x2 __attribute__((ext_vector_type(2)));
typedef int i32x4 __attribute__((ext_vector_type(4)));
using bf16x2_t = __attribute__((ext_vector_type(2))) __bf16;

constexpr int DM = 2048, NB = 2, SEQ = 8192, T = NB * SEQ, DEPTH = 2;
constexpr int MLA_H = 16, MLA_QR = 512, MLA_KVR = 512, MLA_NOPE = 128, MLA_ROPE = 64, MLA_QK = 192, MLA_V = 128, MLA_IN = 1088, MLA_IN_PAD = 1280;
constexpr int DIL_G = 3, DIL_H = 16, DIL_DH = 128, DIL_GW = 2048, DIL_IN = 18432;
constexpr int PEER_H = 8, PEER_NK = 128, PEER_E = 16384, PEER_TOPK = 16;
constexpr float EPS = 1e-6f;
constexpr float LOG2E = 1.4426950408889634f;
constexpr float ACT_F8SCALE = 64.f;
constexpr float DIL_WSCALE = 64.f;

constexpr size_t MiB = 1u << 20;
constexpr size_t al256(size_t x) { return (x + 255) & ~(size_t)255; }
constexpr size_t WS_CTL = 0, CTL_BYTES = 1 * MiB;
constexpr size_t CTL_MOD_OFF = 64 * 1024;
constexpr size_t WS_WIN_MLA = WS_CTL + CTL_BYTES;
constexpr size_t WS_WUQ = WS_WIN_MLA + al256((size_t)MLA_IN_PAD * DM * 2);
constexpr size_t WS_WUKV = WS_WUQ + al256((size_t)3072 * 512 * 2);
constexpr size_t WS_WO_MLA = WS_WUKV + al256((size_t)4096 * 512 * 2);
constexpr size_t WS_WIN_DIL = WS_WO_MLA + al256((size_t)DM * DM * 2);
constexpr size_t WS_WO_DIL = WS_WIN_DIL + al256((size_t)DIL_IN * DM * 2);
constexpr size_t WS_WQ = WS_WO_DIL + al256((size_t)DM * DM * 2);
constexpr size_t WS_SUBK = WS_WQ + al256((size_t)2 * DM * DM * 2);
constexpr size_t WS_UTAB = WS_SUBK + al256((size_t)2 * 8 * 2 * 128 * 128 * 2);
constexpr size_t WS_VTAB = WS_UTAB + al256((size_t)PEER_E * DM);
constexpr size_t WS_USC = WS_VTAB + al256((size_t)PEER_E * DM);
constexpr size_t WS_VSC = WS_USC + al256((size_t)PEER_E * 4);
constexpr size_t WS_HB = WS_VSC + al256((size_t)PEER_E * 4);
constexpr size_t WS_XA = WS_HB + al256((size_t)T * DM * 2);
constexpr size_t WS_PQ = WS_XA + (size_t)T * DM * 4;
constexpr size_t WS_XB = WS_PQ + al256((size_t)T * DM * 2);
constexpr size_t WS_IDX = WS_XB + al256((size_t)T * DM * 4);
constexpr size_t WS_GATE = WS_IDX + al256((size_t)T * 128 * 4);
constexpr size_t WS_R1 = WS_GATE + al256((size_t)T * 128 * 4);
constexpr size_t WS_QRAW = WS_XA, WS_KVRAW = WS_XB, WS_OG = WS_XA, WS_LSE = WS_IDX;
constexpr size_t R1_Z = 0;
constexpr size_t R1_CQN = R1_Z + al256((size_t)T * MLA_IN_PAD * 2);
constexpr size_t R1_CKVN = R1_CQN + al256((size_t)T * 512 * 2);
constexpr size_t R1_Q = R1_CKVN + al256((size_t)T * 512 * 2);
constexpr size_t R1_K = R1_Q + al256((size_t)T * 3072 * 2);
constexpr size_t R1_V = R1_K + al256((size_t)T * 3072 * 2);
constexpr size_t R1_END0 = R1_V + al256((size_t)T * DM * 2);
constexpr size_t R1_ZD = 0;
constexpr size_t R1_END1 = R1_ZD + al256((size_t)SEQ * DIL_IN * 2);
constexpr size_t R1_BYTES = R1_END0 > R1_END1 ? R1_END0 : R1_END1;
constexpr size_t WS_ROPE = WS_R1 + R1_BYTES;
constexpr size_t WS_END = WS_ROPE + al256((size_t)2 * T * 64 * 4);
static_assert(WS_END <= (size_t)1116430848, "workspace must fit the guaranteed minimum");

__device__ __forceinline__ float bf2f(unsigned v) { return __uint_as_float(v << 16); }
__device__ __forceinline__ unsigned cvt_pk_bf16(float lo, float hi) { unsigned r; asm volatile("s_nop 0\n\tv_cvt_pk_bf16_f32 %0, %1, %2" : "=v"(r) : "v"(lo), "v"(hi)); return r; }
__device__ __forceinline__ unsigned bf16_rne_bits(float f) { unsigned u = __float_as_uint(f); u += 0x7FFFu + ((u >> 16) & 1u); return u >> 16; }
__device__ __forceinline__ float bflo(unsigned w) { return __uint_as_float(w << 16); }
__device__ __forceinline__ float bfhi(unsigned w) { return __uint_as_float(w & 0xffff0000u); }
__device__ __forceinline__ float dot2(unsigned a, unsigned b, float acc) { return __builtin_amdgcn_fdot2_f32_bf16(__builtin_bit_cast(bf16x2_t, a), __builtin_bit_cast(bf16x2_t, b), acc, false); }
__device__ __forceinline__ float wave_sum(float v) {
#pragma unroll
    for (int o = 32; o >= 1; o >>= 1) v += __shfl_xor(v, o);
    return v;
}
__device__ __forceinline__ int otid() { int t = (int)threadIdx.x; asm volatile("" : "+v"(t)); return t; }
typedef __attribute__((address_space(1))) unsigned char* gptr_t;
__device__ __forceinline__ unsigned char* ow(unsigned char* p) { gptr_t g = (gptr_t)p; asm volatile("" : "+s"(g)); return (unsigned char*)g; }
__device__ __forceinline__ int obid() { int b = (int)blockIdx.x; asm volatile("" : "+s"(b)); return b; }
__device__ __forceinline__ u32x4 pack8f(f32x4 a, f32x4 b) { u32x4 w = {cvt_pk_bf16(a[0], a[1]), cvt_pk_bf16(a[2], a[3]), cvt_pk_bf16(b[0], b[1]), cvt_pk_bf16(b[2], b[3])}; return w; }
__device__ __forceinline__ void unpack8(u32x4 w, float (&f)[8]) { f[0] = bflo(w.x); f[1] = bfhi(w.x); f[2] = bflo(w.y); f[3] = bfhi(w.y); f[4] = bflo(w.z); f[5] = bfhi(w.z); f[6] = bflo(w.w); f[7] = bfhi(w.w); }
__device__ __forceinline__ void sincos_rev(float ang, float& s, float& c) {
    const double x = (double)ang * 0.15915494309189533577;
    const float fr = (float)(x - __builtin_rint(x));
    s = __builtin_amdgcn_sinf(fr); c = __builtin_amdgcn_cosf(fr);
}

#define XB_TMO      128
#define XB_XCNT(j)  (256  + 64 * (j))
#define XB_XSUB(j)  (1280 + 64 * (j))
#define XB_XGEN(j)  (2304 + 64 * (j))
#define XB_TOP      3328
#define XB_TOPGEN   3392
#define XCD_BAR_WORDS 3456
#define XB_SPIN_CAP (1u << 22)
__device__ __forceinline__ unsigned xb_ld(unsigned* p)              { return __hip_atomic_load(p, __ATOMIC_RELAXED, __HIP_MEMORY_SCOPE_AGENT); }
__device__ __forceinline__ unsigned xb_add(unsigned* p, unsigned v) { return __hip_atomic_fetch_add(p, v, __ATOMIC_RELAXED, __HIP_MEMORY_SCOPE_AGENT); }
__device__ __forceinline__ unsigned xb_xcc_id() { return (unsigned)__builtin_amdgcn_s_getreg((3 << 11) | 20) & 0xFu; }
#define XB_SPIN(cond, bar) do { unsigned _sp = 0; while (cond) { __builtin_amdgcn_s_sleep(1); \
    if ((++_sp & 255u) == 0u) { if (xb_ld(&(bar)[XB_TMO])) break; if (_sp > XB_SPIN_CAP) { atomicAdd(&(bar)[XB_TMO], 1u); break; } } } } while (0)
struct XcdBarrier { unsigned* bar; unsigned x; volatile LAS unsigned* st; };
__device__ __forceinline__ XcdBarrier xcd_barrier_post(unsigned* bar, volatile LAS unsigned* st) {
    XcdBarrier b; b.bar = bar; b.x = xb_xcc_id(); b.st = st;
    if (threadIdx.x == 0) (void)xb_add(&bar[XB_XCNT(b.x)], 1u);
    return b;
}
__device__ __forceinline__ void xcd_barrier_complete(unsigned* bar, unsigned x, unsigned& nloc, unsigned& nx) {
    const unsigned G = gridDim.x * gridDim.y * gridDim.z;
    unsigned sum, cnt, mine, sp = 0u;
    for (;;) {
        sum = 0u; cnt = 0u; mine = 0u;
#pragma unroll
        for (unsigned j = 0; j < 16; ++j) { const unsigned c = xb_ld(&bar[XB_XCNT(j)]); sum += c; cnt += (c > 0u) ? 1u : 0u; mine = (j == x) ? c : mine; }
        if (sum == G) break;
        __builtin_amdgcn_s_sleep(1);
        if ((++sp & 255u) == 0u) { if (xb_ld(&bar[XB_TMO])) break; if (sp > XB_SPIN_CAP) { atomicAdd(&bar[XB_TMO], 1u); break; } }
    }
    nloc = mine > 0u ? mine : 1u; nx = cnt > 0u ? cnt : 1u;
}
__device__ __forceinline__ void xcd_barrier(const XcdBarrier& b) {
    asm volatile("s_waitcnt vmcnt(0)" ::: "memory");
    __syncthreads();
    if (threadIdx.x == 0) {
        unsigned* bar = b.bar;
        __builtin_amdgcn_s_waitcnt(0);
        unsigned nloc = b.st[0], nx = b.st[1];
        if (nloc == 0u) { xcd_barrier_complete(bar, b.x, nloc, nx); b.st[0] = nloc; b.st[1] = nx; }
        const unsigned old = xb_add(&bar[XB_XSUB(b.x)], 1u);
        const unsigned gen = old / nloc;
        if (old + 1u == (gen + 1u) * nloc) {
            __builtin_amdgcn_fence(__ATOMIC_RELEASE, "agent");
            asm volatile("s_waitcnt vmcnt(0)" ::: "memory");
            const unsigned og = xb_add(&bar[XB_TOP], 1u);
            const unsigned tg = og / nx;
            if (og + 1u == (tg + 1u) * nx) xb_add(&bar[XB_TOPGEN], 1u);
            else XB_SPIN(xb_ld(&bar[XB_TOPGEN]) == tg, bar);
            __builtin_amdgcn_fence(__ATOMIC_ACQUIRE, "agent");
            xb_add(&bar[XB_XGEN(b.x)], 1u);
            asm volatile("s_waitcnt vmcnt(0)" ::: "memory");
        } else {
            XB_SPIN(xb_ld(&bar[XB_XGEN(b.x)]) == gen, bar);
            __builtin_amdgcn_fence(__ATOMIC_ACQUIRE, "agent");
            asm volatile("s_waitcnt vmcnt(0)" ::: "memory");
        }
    }
    __syncthreads();
}

namespace pg8 {
constexpr int BM = 256, BK = 64, HALF = 128, HTB = HALF * BK * 2, STAGE_BYTES = 8 * HTB, NXCD = 8, WGM = 8;
__host__ __device__ __forceinline__ int lds_byte(int r, int c) { const int st = (r >> 4) * 2 + (c >> 5), rr = r & 15, cc = c & 31, ob = rr * 64 + cc * 2; return st * 1024 + (ob ^ (((ob >> 9) & 1) << 5)); }
__host__ __device__ __forceinline__ void stage_rc(int b, int& R, int& C) { const int st = b / 1024, sb = b % 1024, swz = sb ^ (((sb >> 9) & 1) << 5); R = (st >> 1) * 16 + swz / 64; C = (st & 1) * 32 + (swz % 64) / 2; }
__host__ __device__ __forceinline__ int perm32(int rho) { const int n = rho >> 4, i = rho & 15; return 8 * (i >> 2) + 4 * n + (i & 3); }
struct Unit { int pm, pn; };
struct Gemm { const bf16_t* A; const bf16_t* Bt; int M, N, K; };
struct StaticOrder {
    int nM, nN, nwg, G, c;
    __host__ __device__ void init(int M, int N, int G_, int c_) { nM = M / BM; nN = N / BM; nwg = nM * nN; G = G_; c = c_; }
    __host__ __device__ bool next(int i, Unit& u) const {
        const long L = (long)i * G + c; if (L >= nwg) return false;
        int wgid = (int)L; { const int q = nwg / NXCD, r = nwg % NXCD, xcd = wgid % NXCD, off = wgid / NXCD; wgid = (xcd < r ? xcd * (q + 1) : r * (q + 1) + (xcd - r) * q) + off; }
        const int nig = WGM * nN, gid = wgid / nig, fm = gid * WGM, gsz = (nM - fm) < WGM ? (nM - fm) : WGM;
        u.pm = fm + ((wgid % nig) % gsz); u.pn = (wgid % nig) / gsz; return true;
    }
    __device__ __forceinline__ void a_ready(const Unit&) const {}
    __device__ __forceinline__ void done(const Unit&) const {}
};
struct EpiBf16 {
    static constexpr bool PERM = true;
    bf16_t* O; int ldc; int mode; const unsigned* cs; const float* sn; const float* g_qn; const float* g_kn; LAS float* xch; float oscale; bf16_t* O2;
    __device__ __forceinline__ void operator()(const f32x4 (&acc)[2][2][4][2], const Unit& u, int wr, int wc, int fr, int fq) const {
        { const int l_ = otid() & 63; fr = l_ & 15; fq = l_ >> 4; }
        const int row0 = u.pm * BM + wr * 64 + fr; const int col0 = u.pn * BM + wc * 32 + 8 * fq;
        if (mode == 2) {
#pragma unroll
            for (int ai = 0; ai < 2; ++ai)
#pragma unroll
                for (int m = 0; m < 4; ++m) { const int r = row0 + ai * HALF + m * 16;
#pragma unroll
                    for (int bj = 0; bj < 2; ++bj) { const f32x4 v0 = acc[ai][bj][m][0] * oscale, v1 = acc[ai][bj][m][1] * oscale;
                        u32x4 w; w.x = cvt_pk_bf16(v0[0], v0[1]); w.y = cvt_pk_bf16(v0[2], v0[3]); w.z = cvt_pk_bf16(v1[0], v1[1]); w.w = cvt_pk_bf16(v1[2], v1[3]);
                        const int d0 = wc * 32 + 8 * fq;
                        *(u32x4*)(O + ((size_t)(((r >> 5) * 8 + u.pn) * 2 + bj) << 12) + (size_t)(((d0 >> 4) * 64 + ((d0 >> 3) & 1) * 32 + (r & 31)) * 8)) = w; } }
            return;
        }
        if (mode == 0) {
#pragma unroll
            for (int ai = 0; ai < 2; ++ai)
#pragma unroll
                for (int m = 0; m < 4; ++m) { bf16_t* rowp = O + (size_t)(row0 + ai * HALF + m * 16) * ldc + col0;
#pragma unroll
                    for (int bj = 0; bj < 2; ++bj) { const f32x4 v0 = acc[ai][bj][m][0] * oscale, v1 = acc[ai][bj][m][1] * oscale;
                        u32x4 w; w.x = cvt_pk_bf16(v0[0], v0[1]); w.y = cvt_pk_bf16(v0[2], v0[3]); w.z = cvt_pk_bf16(v1[0], v1[1]); w.w = cvt_pk_bf16(v1[2], v1[3]);
                        if (bj == 1 && O2 != nullptr) { const int r = row0 + ai * HALF + m * 16;
                            *(u32x4*)(O2 + ((size_t)((r >> 13) * MLA_H + u.pn) * SEQ + (r & (SEQ - 1))) * 128 + wc * 32 + 8 * fq) = w; }
                        else *(u32x4*)(rowp + bj * HALF) = w; } }
            return;
        }
        const int mg = 4 * wc + fq;
        u32x4 csv[2][4];
#pragma unroll
        for (int ai = 0; ai < 2; ++ai)
#pragma unroll
            for (int m = 0; m < 4; ++m) { const int r_ = row0 + ai * HALF + m * 16; csv[ai][m] = *(const u32x4*)(cs + ((size_t)((r_ >> 4) * 16 + mg) * 16 + (r_ & 15)) * 4); }
#pragma unroll
        for (int ai = 0; ai < 2; ++ai)
#pragma unroll
            for (int m = 0; m < 4; ++m)
#pragma unroll
                for (int bj = 0; bj < 2; ++bj) { const f32x4 a0 = acc[ai][bj][m][0], a1 = acc[ai][bj][m][1];
                    float s = (a0[0] * a0[0] + a0[1] * a0[1]) + (a0[2] * a0[2] + a0[3] * a0[3]) + (a1[0] * a1[0] + a1[1] * a1[1]) + (a1[2] * a1[2] + a1[3] * a1[3]);
                    s += __shfl_xor(s, 16); s += __shfl_xor(s, 32); s *= oscale * oscale;
                    if (fq == 0) xch[(((((wr * 2 + ai) * 4 + m) * 16 + fr) * 2 + bj) << 2) + wc] = s; }
        asm volatile("s_waitcnt lgkmcnt(0)" ::: "memory"); __builtin_amdgcn_s_barrier(); asm volatile("" ::: "memory");
        const float QSC = 0.08838834764831845f * 1.4426950408889634f;
#pragma unroll
        for (int bj = 0; bj < 2; ++bj) {
            const int hh = 2 * u.pn + bj, typ = (hh >> 4) % 3, grp = hh / 48;
            const int dsh = 2 * grp, lsh = 13 - dsh;
            bf16_t* hbase = O + (size_t)hh * SEQ * 128 + wc * 32 + 8 * fq;
#define ZROW(s_) ((size_t)((((s_) & ((1 << dsh) - 1)) << lsh) + ((s_) >> dsh)) * 128)
            if (typ == 2) {
#pragma unroll
                for (int ai = 0; ai < 2; ++ai)
#pragma unroll
                    for (int m = 0; m < 4; ++m) { const f32x4 v0 = acc[ai][bj][m][0] * oscale, v1 = acc[ai][bj][m][1] * oscale;
                        u32x4 w; w.x = cvt_pk_bf16(v0[0], v0[1]); w.y = cvt_pk_bf16(v0[2], v0[3]); w.z = cvt_pk_bf16(v1[0], v1[1]); w.w = cvt_pk_bf16(v1[2], v1[3]);
                        *(u32x4*)(hbase + ZROW(row0 + ai * HALF + m * 16)) = w; }
            } else {
                const float* gp = (typ == 0 ? g_qn : g_kn) + grp * 128 + 4 * mg; const float qs = typ == 0 ? QSC : 1.f;
                const f32x4 g1 = *(const f32x4*)gp * qs, g2 = *(const f32x4*)(gp + 64) * qs;
#pragma unroll
                for (int ai = 0; ai < 2; ++ai)
#pragma unroll
                    for (int m = 0; m < 4; ++m) { const int rl = ai * HALF + m * 16;
                        const f32x4 part = *(const LAS f32x4*)(xch + (((((wr * 2 + ai) * 4 + m) * 16 + fr) * 2 + bj) << 2));
                        const float rinv = rsqrtf(((part[0] + part[1]) + (part[2] + part[3])) * (1.f / 128) + 1e-6f) * oscale;
                        const u32x4 cw = csv[ai][m]; const f32x4 c4 = {bflo(cw.x), bflo(cw.y), bflo(cw.z), bflo(cw.w)}, s4 = {bfhi(cw.x), bfhi(cw.y), bfhi(cw.z), bfhi(cw.w)};
                        const f32x4 y1 = acc[ai][bj][m][0] * rinv * g1, y2 = acc[ai][bj][m][1] * rinv * g2;
                        const f32x4 o1 = y1 * c4 - y2 * s4, o2 = y2 * c4 + y1 * s4;
                        u32x4 w; w.x = cvt_pk_bf16(o1[0], o1[1]); w.y = cvt_pk_bf16(o1[2], o1[3]); w.z = cvt_pk_bf16(o2[0], o2[1]); w.w = cvt_pk_bf16(o2[2], o2[3]);
                        *(u32x4*)(hbase + ZROW(row0 + rl)) = w; }
            }
#undef ZROW
        }
    }
};
struct EpiResGate {
    static constexpr bool PERM = true;
    const float* base; const float* gate; int gate_bstride; bf16_t* out; int ldc; float oscale; int base_b16;
    __device__ __forceinline__ void operator()(const f32x4 (&acc)[2][2][4][2], const Unit& u, int wr, int wc, int fr, int fq) const {
        { const int l_ = otid() & 63; fr = l_ & 15; fq = l_ >> 4; }
        const int row0 = u.pm * BM + wr * 64 + fr, col0 = u.pn * BM + wc * 32 + 8 * fq;
        const float* gp = gate + (size_t)((u.pm * BM) / SEQ) * gate_bstride + col0;
        f32x4 gv[2][2];
#pragma unroll
        for (int bj = 0; bj < 2; ++bj)
#pragma unroll
            for (int n = 0; n < 2; ++n) gv[bj][n] = *(const f32x4*)(gp + bj * HALF + n * 4) * oscale;
#pragma unroll
        for (int ai = 0; ai < 2; ++ai) {
            f32x4 bs[4][2][2];
#pragma unroll
            for (int m = 0; m < 4; ++m) { const size_t off = (size_t)(row0 + ai * HALF + m * 16) * ldc + col0;
#pragma unroll
                for (int bj = 0; bj < 2; ++bj) {
                    if (base_b16) { const u32x4 w_ = *(const u32x4*)((const bf16_t*)base + off + bj * HALF);
                        bs[m][bj][0] = f32x4{bflo(w_.x), bfhi(w_.x), bflo(w_.y), bfhi(w_.y)}; bs[m][bj][1] = f32x4{bflo(w_.z), bfhi(w_.z), bflo(w_.w), bfhi(w_.w)}; }
                    else { bs[m][bj][0] = *(const f32x4*)(base + off + bj * HALF); bs[m][bj][1] = *(const f32x4*)(base + off + bj * HALF + 4); } } }
            asm volatile("" ::: "memory");
#pragma unroll
            for (int m = 0; m < 4; ++m) { const size_t off = (size_t)(row0 + ai * HALF + m * 16) * ldc + col0;
#pragma unroll
                for (int bj = 0; bj < 2; ++bj) { const f32x4 o0 = bs[m][bj][0] + gv[bj][0] * acc[ai][bj][m][0], o1 = bs[m][bj][1] + gv[bj][1] * acc[ai][bj][m][1];
                    *(u32x4*)(out + off + bj * HALF) = u32x4{cvt_pk_bf16(o0[0], o0[1]), cvt_pk_bf16(o0[2], o0[3]), cvt_pk_bf16(o1[0], o1[1]), cvt_pk_bf16(o1[2], o1[3])}; } }
            asm volatile("" ::: "memory"); }
    }
};
typedef int i32x8 __attribute__((ext_vector_type(8)));
typedef int i32x4v __attribute__((ext_vector_type(4)));
template <class Epi, class Sched, bool F8 = false>
__device__ __forceinline__ void gemm_phase(LAS unsigned char* lds, const Gemm g, const Sched& S, const Epi& E) {
    const int tid = otid(), wid = __builtin_amdgcn_readfirstlane(tid >> 6), lane = tid & 63, wr = wid >> 2, wc = wid & 3, fr = lane & 15, fq = lane >> 4;
    const int K = g.K, nt = K / BK;
    unsigned voffA[2], voffB[2];
#pragma unroll
    for (int i = 0; i < 2; ++i) { int R, C; stage_rc(tid * 16 + i * 8192, R, C); const int Rb = Epi::PERM ? ((R & ~31) + perm32(R & 31)) : R;
        voffA[i] = (unsigned)(R * K + C) * 2u; voffB[i] = (unsigned)(Rb * K + C) * 2u; }
    const size_t kstep = (size_t)(BK * 2);
    const size_t hstep = (size_t)HALF * K * 2;
    const size_t tstep = 2 * hstep;
    const unsigned ldsw = (unsigned)wid * 1024u;
    const int aoff = lds_byte(wr * 64 + fr, fq * 8), boff = lds_byte(wc * 32 + fr, fq * 8);
#define PG8_SA(b, h) (((b) * 2 + (h)) * HTB)
#define PG8_SB(b, h) ((4 + (b) * 2 + (h)) * HTB)
#define PG8_STAGE(bufoff, gbase, voff) do { _Pragma("unroll") for (int _i = 0; _i < 2; ++_i) \
        __builtin_amdgcn_global_load_lds((const unsigned*)((const char*)(gbase) + (voff)[_i]), (LAS unsigned*)(lds + (bufoff) + ldsw + _i * 8192), 16, 0, 0); } while (0)
#define PG8_LDA(dst, b, h) do { if constexpr (F8) { _Pragma("unroll") for (int m = 0; m < 4; ++m) { const i32x4v lo_ = *(const LAS i32x4v*)(lds + PG8_SA(b, h) + aoff + m * 2048), hi_ = *(const LAS i32x4v*)(lds + PG8_SA(b, h) + aoff + m * 2048 + 1024); \
            dst##8[m] = __builtin_shufflevector(lo_, hi_, 0, 1, 2, 3, 4, 5, 6, 7); } } \
        else { _Pragma("unroll") for (int m = 0; m < 4; ++m) _Pragma("unroll") for (int k = 0; k < 2; ++k) dst[m][k] = *(const LAS bf16x8*)(lds + PG8_SA(b, h) + aoff + m * 2048 + k * 1024); } } while (0)
#define PG8_LDB(dst, b, h) do { if constexpr (F8) { _Pragma("unroll") for (int n = 0; n < 2; ++n) { const i32x4v lo_ = *(const LAS i32x4v*)(lds + PG8_SB(b, h) + boff + n * 2048), hi_ = *(const LAS i32x4v*)(lds + PG8_SB(b, h) + boff + n * 2048 + 1024); \
            dst##8[n] = __builtin_shufflevector(lo_, hi_, 0, 1, 2, 3, 4, 5, 6, 7); } } \
        else { _Pragma("unroll") for (int n = 0; n < 2; ++n) _Pragma("unroll") for (int k = 0; k < 2; ++k) dst[n][k] = *(const LAS bf16x8*)(lds + PG8_SB(b, h) + boff + n * 2048 + k * 1024); } } while (0)
#define PG8_MMA(ai, bj, At, Bt) do { __builtin_amdgcn_s_setprio(1); _Pragma("unroll") for (int m = 0; m < 4; ++m) _Pragma("unroll") for (int n = 0; n < 2; ++n) { \
        if constexpr (F8) asm volatile("v_mfma_scale_f32_16x16x128_f8f6f4 %0, %1, %2, %0, %3, %3 op_sel_hi:[0,0,0]" : "+v"(acc[ai][bj][m][n]) : "v"(Bt##8[n]), "v"(At##8[m]), "v"(mxs));   \
        else { _Pragma("unroll") for (int k = 0; k < 2; ++k) acc[ai][bj][m][n] = __builtin_amdgcn_mfma_f32_16x16x32_bf16(Bt[n][k], At[m][k], acc[ai][bj][m][n], 0, 0, 0); } } \
        __builtin_amdgcn_s_setprio(0); } while (0)
#define PG8_WAIT_V(n) asm volatile("s_waitcnt vmcnt(" #n ")" ::: "memory")
#define PG8_WAIT_L(n) asm volatile("s_waitcnt lgkmcnt(" #n ")" ::: "memory")
#define PG8_BAR __builtin_amdgcn_s_barrier()
#define PG8_SCHED __builtin_amdgcn_sched_barrier(0)
    Unit cur, nxt; int ui = 0;
    if (!S.next(0, cur)) return;
    f32x4 acc[2][2][4][2];
#pragma unroll
    for (int a = 0; a < 2; ++a)
#pragma unroll
        for (int b = 0; b < 2; ++b)
#pragma unroll
            for (int m = 0; m < 4; ++m)
#pragma unroll
                for (int n = 0; n < 2; ++n) acc[a][b][m][n] = (f32x4){0.f, 0.f, 0.f, 0.f};
    bf16x8 At[4][2], B0[2][2], B1[2][2]; i32x8 At8[4], B08[2], B18[2];
    int mxs = 0x7F7F7F7F; asm volatile("" : "+v"(mxs));
    const char* cA = (const char*)g.A + (size_t)cur.pm * tstep; const char* cB = (const char*)g.Bt + (size_t)cur.pn * tstep;
    S.a_ready(cur);
    PG8_STAGE(PG8_SB(0, 0), cB, voffB); PG8_STAGE(PG8_SA(0, 0), cA, voffA); PG8_STAGE(PG8_SB(0, 1), cB + hstep, voffB); PG8_STAGE(PG8_SA(0, 1), cA + hstep, voffA);
    if (wr == 1) PG8_BAR;
    PG8_WAIT_V(4); PG8_BAR;
    PG8_STAGE(PG8_SB(1, 0), cB + kstep, voffB); PG8_STAGE(PG8_SA(1, 0), cA + kstep, voffA); PG8_STAGE(PG8_SB(1, 1), cB + hstep + kstep, voffB);
    PG8_WAIT_V(6); PG8_BAR;
    for (;;) {
        const bool has_next = S.next(ui + 1, nxt);
        const char* nA = has_next ? (const char*)g.A + (size_t)nxt.pm * tstep : cA; const char* nB = has_next ? (const char*)g.Bt + (size_t)nxt.pn * tstep : cB;
        for (int t = 0; t < nt; t += 2) {
            const bool last = (t == nt - 2);
            const char* a1 = cA + (size_t)(t + 1) * kstep;
            const char* a2 = last ? nA : cA + (size_t)(t + 2) * kstep; const char* b2 = last ? nB : cB + (size_t)(t + 2) * kstep;
            const char* a3 = a2 + kstep; const char* b3 = b2 + kstep;
            if (last && has_next) S.a_ready(nxt);
            PG8_LDB(B0, 0, 0); PG8_SCHED; PG8_LDA(At, 0, 0); PG8_STAGE(PG8_SA(1, 1), a1 + hstep, voffA);
            PG8_WAIT_L(8); PG8_BAR; PG8_WAIT_L(0); PG8_MMA(0, 0, At, B0); PG8_BAR; PG8_SCHED;
            PG8_LDB(B1, 0, 1); PG8_STAGE(PG8_SB(0, 0), b2, voffB);
            PG8_BAR; PG8_WAIT_L(0); PG8_MMA(0, 1, At, B1); PG8_BAR;
            PG8_LDA(At, 0, 1); PG8_STAGE(PG8_SA(0, 0), a2, voffA);
            PG8_BAR; PG8_WAIT_L(0); PG8_MMA(1, 0, At, B0); PG8_BAR; PG8_SCHED;
            PG8_STAGE(PG8_SB(0, 1), b2 + hstep, voffB);
            PG8_WAIT_V(6); PG8_BAR; PG8_MMA(1, 1, At, B1); PG8_BAR;
            PG8_LDB(B0, 1, 0); PG8_SCHED; PG8_LDA(At, 1, 0); PG8_STAGE(PG8_SA(0, 1), a2 + hstep, voffA);
            PG8_WAIT_L(8); PG8_BAR; PG8_WAIT_L(0); PG8_MMA(0, 0, At, B0); PG8_BAR; PG8_SCHED;
            PG8_LDB(B1, 1, 1); PG8_STAGE(PG8_SB(1, 0), b3, voffB);
            PG8_BAR; PG8_WAIT_L(0); PG8_MMA(0, 1, At, B1); PG8_BAR;
            PG8_LDA(At, 1, 1); PG8_STAGE(PG8_SA(1, 0), a3, voffA);
            PG8_BAR; PG8_WAIT_L(0); PG8_MMA(1, 0, At, B0); PG8_BAR; PG8_SCHED;
            PG8_STAGE(PG8_SB(1, 1), b3 + hstep, voffB);
            PG8_WAIT_V(6); PG8_BAR; PG8_MMA(1, 1, At, B1); PG8_BAR;
        }
        if (wr == 0) PG8_BAR;
        if constexpr (F8) asm volatile("s_nop 15\n\ts_nop 15" ::: "memory");
        E(acc, cur, wr, wc, fr, fq); S.done(cur);
        if (!has_next) break;
#pragma unroll
        for (int a = 0; a < 2; ++a)
#pragma unroll
            for (int b = 0; b < 2; ++b)
#pragma unroll
                for (int m = 0; m < 4; ++m)
#pragma unroll
                    for (int n = 0; n < 2; ++n) acc[a][b][m][n] = (f32x4){0.f, 0.f, 0.f, 0.f};
        cur = nxt; cA = nA; cB = nB; ++ui;
        if (wr == 1) PG8_BAR;
    }
    PG8_WAIT_V(0);
    PG8_BAR;
#undef PG8_SA
#undef PG8_SB
#undef PG8_STAGE
#undef PG8_LDA
#undef PG8_LDB
#undef PG8_MMA
#undef PG8_WAIT_V
#undef PG8_WAIT_L
#undef PG8_BAR
#undef PG8_SCHED
}
}

namespace at {
constexpr int SHM_V = 64 * 128 * 2;
constexpr float THR = 8.f;
#define SBAR() __builtin_amdgcn_sched_barrier(0)
__device__ __forceinline__ int v_st(int k, int c) { const int kk = (k & ~0xC) | ((k & 4) << 1) | ((k & 8) >> 1); return ((kk >> 3) * 4 + (c >> 5)) * 512 + ((kk & 7) * 32 + (c & 31)) * 2; }
__device__ __forceinline__ int v_rd_base(int lane) { return ((lane & 3) << 3) | (((lane >> 2) & 3) << 6) | (((lane >> 4) & 1) << 5) | (((lane >> 5) & 1) << 8); }
constexpr int v_rd_off(int d0, int ks, int half) { return d0 * 512 + ks * 4096 + half * 2048; }
__device__ __forceinline__ int crow(int r, int hi) { return (r & 3) + 8 * (r >> 2) + 4 * hi; }
__device__ __forceinline__ void mask_tile(f32x16& p0, f32x16& p1, int dq, unsigned W) {
    const float NEG = -__builtin_inff();
#pragma unroll
    for (int r = 0; r < 16; ++r) {
        const int c = (r & 3) + 8 * (r >> 2);
        if ((unsigned)(dq - c) >= W) p0[r] = NEG;
        if ((unsigned)(dq - c - 32) >= W) p1[r] = NEG;
    }
}
__device__ __forceinline__ void partialSM(f32x16& p0, f32x16& p1, float& m_reg, float& alpha) {
    float pmax = p0[0];
#pragma unroll
    for (int r = 1; r < 16; ++r) pmax = fmaxf(pmax, p0[r]);
#pragma unroll
    for (int r = 0; r < 16; ++r) pmax = fmaxf(pmax, p1[r]);
    { auto rr = __builtin_amdgcn_permlane32_swap(__float_as_uint(pmax), __float_as_uint(pmax), false, false);
      pmax = fmaxf(__uint_as_float(rr[0]), __uint_as_float(rr[1])); }
    float mn;
    if (__builtin_expect(__all((pmax - m_reg) <= THR), 1)) { mn = m_reg; alpha = 1.f; }
    else { mn = fmaxf(m_reg, pmax); alpha = __builtin_amdgcn_exp2f(m_reg - mn); m_reg = mn; }
#pragma unroll
    for (int r = 0; r < 16; ++r) p0[r] = __builtin_amdgcn_exp2f(p0[r] - mn);
#pragma unroll
    for (int r = 0; r < 16; ++r) p1[r] = __builtin_amdgcn_exp2f(p1[r] - mn);
}
__device__ __forceinline__ void finishSM(f32x16& p0, f32x16& p1, float alpha, float& l_reg, bf16x8& pa0, bf16x8& pa1, bf16x8& pa2, bf16x8& pa3) {
    float ps = 0;
#pragma unroll
    for (int r = 0; r < 16; ++r) ps += p0[r];
#pragma unroll
    for (int r = 0; r < 16; ++r) ps += p1[r];
    { auto rr = __builtin_amdgcn_permlane32_swap(__float_as_uint(ps), __float_as_uint(ps), false, false);
      ps = __uint_as_float(rr[0]) + __uint_as_float(rr[1]); }
    l_reg = l_reg * alpha + ps;
#define PK4(P, B_, OUT) do { unsigned a0 = cvt_pk_bf16(P[B_+0], P[B_+1]), a1 = cvt_pk_bf16(P[B_+2], P[B_+3]);                          \
        unsigned b0 = cvt_pk_bf16(P[B_+4], P[B_+5]), b1 = cvt_pk_bf16(P[B_+6], P[B_+7]);                                             \
        auto r0 = __builtin_amdgcn_permlane32_swap(a0, b0, false, false); auto r1 = __builtin_amdgcn_permlane32_swap(a1, b1, false, false); \
        u32x4 w = {r0[0], r1[0], r0[1], r1[1]}; OUT = *reinterpret_cast<bf16x8*>(&w); } while (0)
    PK4(p0, 0, pa0); PK4(p0, 8, pa1); PK4(p1, 0, pa2); PK4(p1, 8, pa3);
#undef PK4
}
template <int KP, int ND>
__device__ __forceinline__ void qkt(f32x16& p0, f32x16& p1, const LAS char* Kb, int r32, int hi, const bf16x8* qr) {
    p0 = f32x16{}; p1 = f32x16{};
    __builtin_amdgcn_s_setprio(1);
    const LAS char* ka = Kb + r32 * KP + hi * 16;
#pragma unroll
    for (int d0 = 0; d0 < ND; ++d0) {
        const bf16x8 b0 = *reinterpret_cast<const LAS bf16x8*>(ka + d0 * 32);
        const bf16x8 b1 = *reinterpret_cast<const LAS bf16x8*>(ka + 32 * KP + d0 * 32);
        p0 = __builtin_amdgcn_mfma_f32_32x32x16_bf16(b0, qr[d0], p0, 0, 0, 0);
        p1 = __builtin_amdgcn_mfma_f32_32x32x16_bf16(b1, qr[d0], p1, 0, 0, 0);
        if ((d0 & 3) == 3) SBAR(); }
    __builtin_amdgcn_s_setprio(0);
}
template <int VB>
__device__ __forceinline__ void pv_tile(f32x16* o, int vb0, bf16x8 pa0, bf16x8 pa1, bf16x8 pa2, bf16x8 pa3) {
#define TRRD(dst, off) asm volatile("ds_read_b64_tr_b16 %0, %1 offset:%2" : "=&v"(dst) : "v"(vb0), "i"(off) : "memory")
#define PV_D0(d0) do { s16x4 l0, l1, l2, l3, h0, h1, h2, h3; constexpr int b_ = VB * SHM_V + v_rd_off(d0, 0, 0); \
        TRRD(l0, b_); TRRD(h0, b_ + 2048); TRRD(l1, b_ + 4096); TRRD(h1, b_ + 6144); TRRD(l2, b_ + 8192); TRRD(h2, b_ + 10240); TRRD(l3, b_ + 12288); TRRD(h3, b_ + 14336); \
        asm volatile("s_waitcnt lgkmcnt(0)" ::: "memory"); SBAR();   \
        o[d0] = __builtin_amdgcn_mfma_f32_32x32x16_bf16(pa0, (bf16x8){l0[0], l0[1], l0[2], l0[3], h0[0], h0[1], h0[2], h0[3]}, o[d0], 0, 0, 0);   \
        o[d0] = __builtin_amdgcn_mfma_f32_32x32x16_bf16(pa1, (bf16x8){l1[0], l1[1], l1[2], l1[3], h1[0], h1[1], h1[2], h1[3]}, o[d0], 0, 0, 0);   \
        o[d0] = __builtin_amdgcn_mfma_f32_32x32x16_bf16(pa2, (bf16x8){l2[0], l2[1], l2[2], l2[3], h2[0], h2[1], h2[2], h2[3]}, o[d0], 0, 0, 0);   \
        o[d0] = __builtin_amdgcn_mfma_f32_32x32x16_bf16(pa3, (bf16x8){l3[0], l3[1], l3[2], l3[3], h3[0], h3[1], h3[2], h3[3]}, o[d0], 0, 0, 0); } while (0)
    PV_D0(0); PV_D0(1); PV_D0(2); PV_D0(3);
#undef PV_D0
#undef TRRD
}
struct Item { const bf16_t* Q; const bf16_t* K; const bf16_t* V; bf16_t* O; float* LSE; long qs, ks, vs, os, ls; int i0, W, L, o_f8; };
template <int DQK>
__device__ __forceinline__ void attn_block(const Item& it, LAS char* lds) {
    constexpr int KP = DQK * 2 + 16, KBYTES = 64 * KP, ND = DQK / 16, CPR = DQK / 8, NKC = (64 * CPR) / 512;
    const int tid = otid(), wid = __builtin_amdgcn_readfirstlane(tid >> 6), lane = tid & 63, r32 = lane & 31, hi = lane >> 5;
    LAS char* V_lds = lds; LAS char* K_lds = lds + 3 * SHM_V;
    LAS float* wsf = (LAS float*)(lds + 3 * SHM_V + 3 * KBYTES) + wid * 64; LAS float* li_l = wsf; LAS float* al_l = wsf + 32;
    const int W = it.W, i0 = it.i0;
    const int qlo = i0 + wid * 32, qm = qlo + r32 - 4 * hi;
    const int lowk = i0 - (W - 1); const int j_lo = lowk > 0 ? lowk / 64 : 0;
    int j_hi = (i0 + 255) / 64 + 1; if (j_hi > it.L / 64) j_hi = it.L / 64;
    const int NT = j_hi - j_lo;
    bf16x8 qr[ND];
    { const bf16_t* qrow = it.Q + (size_t)(qlo + r32) * it.qs + hi * 8;
#pragma unroll
      for (int d0 = 0; d0 < ND; ++d0) qr[d0] = *reinterpret_cast<const bf16x8*>(qrow + d0 * 16); }
    unsigned kgo[NKC], klo[NKC];
#pragma unroll
    for (int i = 0; i < NKC; ++i) { const int c = tid + 512 * i, kr_ = c / CPR, kc_ = c % CPR; kgo[i] = (unsigned)(kr_ * (int)it.ks * 2 + kc_ * 16); klo[i] = (unsigned)(kr_ * KP + kc_ * 16); }
    const int sr = tid >> 4, sc = (tid & 15) * 8, vst0 = v_st(sr, sc), vst1 = v_st(32 + sr, sc);
    const unsigned vgo0 = (unsigned)(sr * (int)it.vs * 2 + sc * 2), vgo1 = (unsigned)((32 + sr) * (int)it.vs * 2 + sc * 2);
    const int vb0 = (int)(uintptr_t)V_lds + v_rd_base(lane);
    bf16x8 stK[NKC], stV0, stV1;
#define AT_LOAD(t) do { const char* kt_ = (const char*)it.K + (size_t)(j_lo + (t)) * 64 * it.ks * 2; const char* vt_ = (const char*)it.V + (size_t)(j_lo + (t)) * 64 * it.vs * 2; \
        _Pragma("unroll") for (int i = 0; i < NKC; ++i) stK[i] = *reinterpret_cast<const bf16x8*>(kt_ + (size_t)kgo[i]); \
        stV0 = *reinterpret_cast<const bf16x8*>(vt_ + (size_t)vgo0); stV1 = *reinterpret_cast<const bf16x8*>(vt_ + (size_t)vgo1); } while (0)
#define AT_WRITE(bf) do { _Pragma("unroll") for (int i = 0; i < NKC; ++i) *reinterpret_cast<LAS bf16x8*>(K_lds + (bf) * KBYTES + klo[i]) = stK[i]; \
        *reinterpret_cast<LAS bf16x8*>(V_lds + (bf) * SHM_V + vst0) = stV0; *reinterpret_cast<LAS bf16x8*>(V_lds + (bf) * SHM_V + vst1) = stV1; } while (0)
    float m_reg = -1e30f, l_reg = 0.f; f32x16 o[4] = {};
    const bool late = wid >= 4;
    f32x16 p0, p1; bool pend = false;
#define AT_PRO() do { AT_LOAD(0); AT_WRITE(0); if (NT > 1) AT_LOAD(1); __syncthreads(); } while (0)
#define AT_SMPV(BFV) do { float alpha; bf16x8 pa0, pa1, pa2, pa3; \
        partialSM(p0, p1, m_reg, alpha); \
        if (__any(alpha < 1.f)) { if (hi == 0) al_l[r32] = alpha; asm volatile("s_waitcnt lgkmcnt(0)" ::: "memory"); \
            _Pragma("unroll") for (int d_ = 0; d_ < 4; ++d_) _Pragma("unroll") for (int r = 0; r < 16; ++r) o[d_][r] *= al_l[crow(r, hi)]; } \
        finishSM(p0, p1, alpha, l_reg, pa0, pa1, pa2, pa3); SBAR(); \
        pv_tile<BFV>(o, vb0, pa0, pa1, pa2, pa3); } while (0)
#define AT_QK(t, BF) do { const int kb = (j_lo + (t)) * 64; \
        qkt<KP, ND>(p0, p1, K_lds + (BF) * KBYTES, r32, hi, qr); \
        if (kb + 63 > qlo || kb <= qlo + 31 - W) mask_tile(p0, p1, qm - kb, (unsigned)W); } while (0)
#define AT_ACTIVE(t) ((j_lo + (t)) * 64 <= qlo + 31 && (j_lo + (t)) * 64 + 63 >= qlo - (W - 1))
#define AT_STAGE(t, BFN) do { if ((t) + 1 < NT) { AT_WRITE(BFN); if ((t) + 2 < NT) AT_LOAD((t) + 2); } } while (0)
    if (!late) {
        asm volatile("; early half" ::: "memory"); AT_PRO();
#define AT_STEP(t, BF, BFN) do { AT_STAGE(t, BFN); if (AT_ACTIVE(t)) { AT_QK(t, BF); AT_SMPV(BF); } __syncthreads(); } while (0)
        for (int t = 0; t < NT; t += 3) {
            AT_STEP(t, 0, 1);
            if (t + 1 < NT) AT_STEP(t + 1, 1, 2);
            if (t + 2 < NT) AT_STEP(t + 2, 2, 0);
        }
#undef AT_STEP
    } else {
        asm volatile("; late half" ::: "memory"); AT_PRO();
#define AT_STEP(t, BF, BFN, BFP) do { AT_STAGE(t, BFN); if (pend) { AT_SMPV(BFP); } pend = AT_ACTIVE(t); if (pend) { AT_QK(t, BF); } __syncthreads(); } while (0)
        for (int t = 0; t < NT; t += 3) {
            AT_STEP(t, 0, 1, 2);
            if (t + 1 < NT) AT_STEP(t + 1, 1, 2, 0);
            if (t + 2 < NT) AT_STEP(t + 2, 2, 0, 1);
        }
#undef AT_STEP
        if (pend) { const int lastslot = (NT - 1) % 3;
            if (lastslot == 0) AT_SMPV(0); else if (lastslot == 1) AT_SMPV(1); else AT_SMPV(2); }
    }
#undef AT_STAGE
#undef AT_PRO
#undef AT_SMPV
#undef AT_QK
#undef AT_ACTIVE
#undef AT_STEP
#undef AT_LOAD
#undef AT_WRITE
    __syncthreads();
    if (hi == 0) li_l[r32] = l_reg;
    asm volatile("s_waitcnt lgkmcnt(0)" ::: "memory");
    LAS char* ow = lds + wid * 8192;
#pragma unroll
    for (int r = 0; r < 16; ++r) { const int orow = crow(r, hi); const float rl = __builtin_amdgcn_rcpf(li_l[orow]);
#pragma unroll
        for (int d0 = 0; d0 < 4; ++d0) { const float v = o[d0][r] * rl; const float vn = __shfl_xor(v, 1);
            if ((r32 & 1) == 0) *reinterpret_cast<LAS unsigned*>(ow + orow * 256 + (d0 * 32 + r32) * 2) = cvt_pk_bf16(v, vn); } }
    asm volatile("s_waitcnt lgkmcnt(0)" ::: "memory");
#pragma unroll
    for (int k = 0; k < 8; ++k) { const int row = k * 4 + (lane >> 4), ch = lane & 15;
        const u32x4 w = *reinterpret_cast<const LAS u32x4*>(ow + row * 256 + ch * 16);
        if (it.o_f8) { float f[8]; unpack8(w, f);
            int q0 = __builtin_amdgcn_cvt_pk_fp8_f32(f[0] * ACT_F8SCALE, f[1] * ACT_F8SCALE, 0, false); q0 = __builtin_amdgcn_cvt_pk_fp8_f32(f[2] * ACT_F8SCALE, f[3] * ACT_F8SCALE, q0, true);
            int q1 = __builtin_amdgcn_cvt_pk_fp8_f32(f[4] * ACT_F8SCALE, f[5] * ACT_F8SCALE, 0, false); q1 = __builtin_amdgcn_cvt_pk_fp8_f32(f[6] * ACT_F8SCALE, f[7] * ACT_F8SCALE, q1, true);
            u32x2 w8 = {(unsigned)q0, (unsigned)q1}; *(u32x2*)((unsigned char*)it.O + (size_t)(qlo + row) * it.os + ch * 8) = w8; }
        else *(u32x4*)(it.O + (size_t)(qlo + row) * it.os + ch * 8) = w; }
    if (it.LSE != nullptr && hi == 0) it.LSE[(size_t)(qlo + r32) * it.ls] = m_reg + __builtin_amdgcn_logf(l_reg);
    __syncthreads();
}
}

struct Args {
    const float* x; const float* c; const int* pos; const float* ada_w; const float* ada_b; const float* norm_g;
    const float* mla_w_in; const float* mla_g_q; const float* mla_w_uq; const float* mla_g_kv; const float* mla_w_ukv; const float* mla_g_qn; const float* mla_g_kn; const float* mla_w_o;
    const float* dil_w_in; const float* dil_g_qn; const float* dil_g_kn; const float* dil_w_o;
    const float* peer_w_q; const float* peer_sub_keys; const float* peer_u; const float* peer_v;
    float* out; unsigned char* ws; int ph_lo, ph_hi;
};
constexpr int LDS_MAIN = 128 * 1024, LDS_XCH = LDS_MAIN + 1024, LDS_BYTES = LDS_XCH + 8192;

struct TrJob { const float* src; bf16_t* dst; int K, N, Npad; int perm; float f8scale; };
__device__ __forceinline__ void tr_load(const TrJob& j, int u, int ntk, int tid, f32x4 (&v)[4]) {
    const int k0 = (u % ntk) * 128, n0 = (u / ntk) * 64, r = tid >> 4, c4 = (tid & 15) * 4;
    int sc = n0 + c4;
    if (j.perm && ((sc >> 11) % 3) < 2) { const int p = sc & 127, mgrp = p >> 3; sc = (sc & ~127) + ((p & 4) ? 64 + 4 * mgrp : 4 * mgrp); }
#pragma unroll
    for (int q2 = 0; q2 < 4; ++q2) { v[q2] = (f32x4){0.f, 0.f, 0.f, 0.f}; if (n0 + c4 < j.N) v[q2] = __builtin_nontemporal_load((const f32x4*)(j.src + (size_t)(k0 + r + 32 * q2) * j.N + sc)); }
}
__device__ __forceinline__ void transpose_job(const TrJob& j, int u0, int G, LAS float* tile) {
    const int tid = otid(); const int ntk = j.K / 128, nt = ntk * (j.Npad / 64);
    if (u0 >= nt) return;
    f32x4 v[4]; tr_load(j, u0, ntk, tid, v);
    for (int u = u0; u < nt; u += G) {
        const int k0 = (u % ntk) * 128, n0 = (u / ntk) * 64;
        { const int r = tid >> 4, c4 = (tid & 15) * 4;
#pragma unroll
          for (int q2 = 0; q2 < 4; ++q2) { const int rr = r + 32 * q2; tile[rr * 65 + c4 + 0] = v[q2][0]; tile[rr * 65 + c4 + 1] = v[q2][1]; tile[rr * 65 + c4 + 2] = v[q2][2]; tile[rr * 65 + c4 + 3] = v[q2][3]; } }
        __syncthreads();
        if (u + G < nt) tr_load(j, u + G, ntk, tid, v);
        { const int n = tid >> 3, k16 = (tid & 7) * 16; float f[16];
#pragma unroll
          for (int e = 0; e < 16; ++e) f[e] = tile[(k16 + e) * 65 + n];
          if (j.f8scale != 0.f) { const float sc_ = j.f8scale; unsigned p[4];
#pragma unroll
              for (int q = 0; q < 4; ++q) { int t_ = __builtin_amdgcn_cvt_pk_fp8_f32(f[4 * q] * sc_, f[4 * q + 1] * sc_, 0, false); t_ = __builtin_amdgcn_cvt_pk_fp8_f32(f[4 * q + 2] * sc_, f[4 * q + 3] * sc_, t_, true); p[q] = (unsigned)t_; }
              *(u32x4*)((unsigned char*)j.dst + (size_t)(n0 + n) * j.K + k0 + k16) = u32x4{p[0], p[1], p[2], p[3]}; }
          else { u32x4 w0 = {cvt_pk_bf16(f[0], f[1]), cvt_pk_bf16(f[2], f[3]), cvt_pk_bf16(f[4], f[5]), cvt_pk_bf16(f[6], f[7])}, w1 = {cvt_pk_bf16(f[8], f[9]), cvt_pk_bf16(f[10], f[11]), cvt_pk_bf16(f[12], f[13]), cvt_pk_bf16(f[14], f[15])};
              *(u32x4*)(j.dst + (size_t)(n0 + n) * j.K + k0 + k16) = w0; *(u32x4*)(j.dst + (size_t)(n0 + n) * j.K + k0 + k16 + 8) = w1; } }
        __syncthreads();
    }
}
__device__ __forceinline__ void convert_flat(const float* src, bf16_t* dst, size_t n, size_t i0, size_t stride) {
    for (size_t i = i0 * 8; i < n; i += stride * 8) { const f32x4 a = *(const f32x4*)(src + i), b = *(const f32x4*)(src + i + 4); *(u32x4*)(dst + i) = pack8f(a, b); }
}
__device__ __forceinline__ void prologue_phase(const Args& A, LAS unsigned char* lds) {
    const int tid = otid(), G = gridDim.x, bid = obid();
    unsigned char* ws = A.ws;
    { LAS float* sl = (LAS float*)lds;
      LAS float* part = sl + 2 * DM;
      float* MOD = (float*)(ws + WS_CTL + CTL_MOD_OFF);
      for (int u = bid; u < 2 * 96; u += G) {
          const int l = u / 96, cc = u % 96;
          __syncthreads();
          for (int i = tid; i < 2 * DM; i += 512) { const float v = A.c[i]; sl[i] = v / (1.f + __expf(-v)); }
          __syncthreads();
          const int c4 = tid & 31, dg = tid >> 5; const int col = cc * 128 + 4 * c4;
          f32x4 a0 = {0.f, 0.f, 0.f, 0.f}, a1 = {0.f, 0.f, 0.f, 0.f};
          const float* wp = A.ada_w + ((size_t)l * DM + dg) * (6 * DM) + col;
#pragma unroll 1
          for (int i0 = 0; i0 < 128; i0 += 16) {
              f32x4 w[16];
#pragma unroll
              for (int k = 0; k < 16; ++k) w[k] = __builtin_nontemporal_load((const f32x4*)(wp + (size_t)(i0 + k) * 16 * (6 * DM)));
#pragma unroll
              for (int k = 0; k < 16; ++k) { const int d = dg + 16 * (i0 + k); a0 += w[k] * sl[d]; a1 += w[k] * sl[DM + d]; }
          }
          *(LAS f32x4*)(part + (dg * 2 + 0) * 128 + 4 * c4) = a0; *(LAS f32x4*)(part + (dg * 2 + 1) * 128 + 4 * c4) = a1;
          __syncthreads();
          if (tid < 256) { const int b = tid >> 7, cq = tid & 127; float s = A.ada_b[l * 6 * DM + cc * 128 + cq];
#pragma unroll
              for (int g2 = 0; g2 < 16; ++g2) s += part[(g2 * 2 + b) * 128 + cq];
              MOD[((size_t)l * 2 + b) * 6 * DM + cc * 128 + cq] = s; }
      }
      __syncthreads(); }
    { int base = 0;
#define TR_JOB(SRC, DST, KK, NN, NP, PM, F8S) do { TrJob j; j.src = (SRC); j.dst = (DST); j.K = (KK); j.N = (NN); j.Npad = (NP); j.perm = (PM); j.f8scale = (F8S); const int nt = (j.K / 128) * (j.Npad / 64); \
          int u = bid - (base % G); if (u < 0) u += G; transpose_job(j, u, G, (LAS float*)lds); base += nt; } while (0)
      TR_JOB(A.mla_w_in, (bf16_t*)(ws + WS_WIN_MLA), DM, MLA_IN, MLA_IN_PAD, 0, DIL_WSCALE);
      TR_JOB(A.mla_w_uq, (bf16_t*)(ws + WS_WUQ), 512, 3072, 3072, 0, DIL_WSCALE);
      TR_JOB(A.mla_w_ukv, (bf16_t*)(ws + WS_WUKV), 512, 4096, 4096, 0, DIL_WSCALE);
      TR_JOB(A.mla_w_o, (bf16_t*)(ws + WS_WO_MLA), DM, DM, DM, 0, DIL_WSCALE);
      TR_JOB(A.dil_w_in, (bf16_t*)(ws + WS_WIN_DIL), DM, DIL_IN, DIL_IN, 1, DIL_WSCALE);
      TR_JOB(A.dil_w_o, (bf16_t*)(ws + WS_WO_DIL), DM, DM, DM, 0, DIL_WSCALE);
      TR_JOB(A.peer_w_q, (bf16_t*)(ws + WS_WQ), DM, DM, DM, 0, 0.f);
      TR_JOB(A.peer_w_q + (size_t)DM * DM, (bf16_t*)(ws + WS_WQ) + (size_t)DM * DM, DM, DM, DM, 0, 0.f);
#undef TR_JOB
    }
    { const size_t i0 = (size_t)bid * 512 + tid, stride = (size_t)G * 512;
      { bf16_t* sk = (bf16_t*)(ws + WS_SUBK);
        for (size_t i = i0 * 8; i < (size_t)2 * 8 * 2 * 128 * 128; i += stride * 8) { const f32x4 a = *(const f32x4*)(A.peer_sub_keys + i), b = *(const f32x4*)(A.peer_sub_keys + i + 4);
            const size_t blk = i >> 14; const int w_ = (int)(i & 16383), key = w_ >> 7, d0 = w_ & 127;
            const size_t o_ = (blk << 14) + (size_t)((((key >> 5) * 8 + (d0 >> 4)) * 64 + ((d0 >> 3) & 1) * 32 + (key & 31)) * 8);
            *(u32x4*)(sk + o_) = pack8f(a, b); } }
      unsigned* csT = (unsigned*)(ws + WS_ROPE);
      for (size_t i = i0; i < (size_t)T * 64; i += stride) { const int tok = (int)(i >> 6), fi = (int)(i & 63); const float inv = exp2f(-(float)fi * (13.287712379549449f / 64.f));
          float s_, c_; sincos_rev((float)A.pos[tok] * inv, s_, c_); csT[(((size_t)(tok >> 4) * 16 + (fi >> 2)) * 16 + (tok & 15)) * 4 + (fi & 3)] = bf16_rne_bits(c_) | (bf16_rne_bits(s_) << 16); } }
}
__device__ __forceinline__ void table_row_store(const f32x4 (&v)[8], float mx, int e, unsigned char* __restrict__ dst, float* __restrict__ scales, int lane) {
#pragma unroll
    for (int o = 32; o >= 1; o >>= 1) mx = fmaxf(mx, __shfl_xor(mx, o));
    const int ex = (int)((__float_as_uint(mx) >> 23) & 0xff);
    const float scale = ex == 0 ? 1.f : __uint_as_float((unsigned)(ex - 7 > 1 ? ex - 7 : 1) << 23);
    const float inv = 1.f / scale;
    if (lane == 0) scales[e] = scale;
#pragma unroll
    for (int k = 0; k < 8; ++k) { int p = __builtin_amdgcn_cvt_pk_fp8_f32(v[k][0] * inv, v[k][1] * inv, 0, false); p = __builtin_amdgcn_cvt_pk_fp8_f32(v[k][2] * inv, v[k][3] * inv, p, true);
        const int c = 2 * k + (lane >> 5); *(int*)(dst + ((size_t)c * PEER_E + e) * 128 + 4 * (lane & 31)) = p; }
}
__device__ __forceinline__ void table_row_store4(const f32x4 (&v)[8], float mx, float ss, int e, unsigned char* __restrict__ dst, float* __restrict__ scales, int lane) {
#pragma unroll
    for (int o = 32; o >= 1; o >>= 1) { mx = fmaxf(mx, __shfl_xor(mx, o)); ss += __shfl_xor(ss, o); }
    float scale = fmaxf(sqrtf(ss * (1.f / DM)) * (1.f / 2.1f), mx * 0.125f);
    if (!(scale > 0.f)) scale = 1.f;
    const float inv = 1.f / scale;
    if (lane == 0) scales[2 * e] = scale;
#pragma unroll
    for (int k = 0; k < 8; ++k) { unsigned p = __builtin_amdgcn_cvt_scalef32_pk_fp4_f32(0u, v[k][0] * inv, v[k][1] * inv, 1.0f, 0); p = __builtin_amdgcn_cvt_scalef32_pk_fp4_f32(p, v[k][2] * inv, v[k][3] * inv, 1.0f, 1);
        *(unsigned short*)(dst + ((size_t)k * PEER_E + e) * 128 + 2 * lane) = (unsigned short)p; }
}
__device__ __forceinline__ void table_rows_fp8(const float* __restrict__ src, unsigned char* __restrict__ dst, float* __restrict__ scales, int bid, int nb, int wv, int lane, bool f4) {
    for (int run = bid; run < PEER_E / 64; run += nb) {
#pragma unroll 1
        for (int i = 0; i < 8; i += 2) {
            const int e0 = run * 64 + wv * 8 + i, e1 = e0 + 1;
            f32x4 va[8], vb[8]; float ma = 0.f, mb = 0.f;
#pragma unroll
            for (int k = 0; k < 8; ++k) { va[k] = __builtin_nontemporal_load((const f32x4*)(src + (size_t)e0 * DM + k * 256 + lane * 4)); vb[k] = __builtin_nontemporal_load((const f32x4*)(src + (size_t)e1 * DM + k * 256 + lane * 4)); }
#pragma unroll
            for (int k = 0; k < 8; ++k) { ma = fmaxf(ma, fmaxf(fmaxf(fabsf(va[k][0]), fabsf(va[k][1])), fmaxf(fabsf(va[k][2]), fabsf(va[k][3])))); mb = fmaxf(mb, fmaxf(fmaxf(fabsf(vb[k][0]), fabsf(vb[k][1])), fmaxf(fabsf(vb[k][2]), fabsf(vb[k][3])))); }
            if (f4) { float sa_ = 0.f, sb_ = 0.f;
#pragma unroll
                for (int k = 0; k < 8; ++k) { sa_ += (va[k][0] * va[k][0] + va[k][1] * va[k][1]) + (va[k][2] * va[k][2] + va[k][3] * va[k][3]); sb_ += (vb[k][0] * vb[k][0] + vb[k][1] * vb[k][1]) + (vb[k][2] * vb[k][2] + vb[k][3] * vb[k][3]); }
                table_row_store4(va, ma, sa_, e0, dst, scales, lane); table_row_store4(vb, mb, sb_, e1, dst, scales, lane); }
            else { table_row_store(va, ma, e0, dst, scales, lane); table_row_store(vb, mb, e1, dst, scales, lane); }
        }
    }
}
__device__ __forceinline__ void tables_phase(const float* u, const float* v, unsigned char* U, unsigned char* V, float* usc, float* vsc) {
    const int tid_ = otid(), lane = tid_ & 63, wv = tid_ >> 6, bid = obid(), nb = gridDim.x;
    table_rows_fp8(u, U, usc, bid, nb, wv, lane, true); table_rows_fp8(v, V, vsc, bid, nb, wv, lane, true);
}

__device__ __forceinline__ void norm_phase(const float* __restrict__ xin, const float* __restrict__ gain, const float* __restrict__ modl  , int shift_off, int scale_off, bf16_t* __restrict__ out, int f8  , unsigned char* __restrict__ out8b = nullptr  , int inb16 = 0  ) {
    const int tid_ = otid(), lane = tid_ & 63, gw = obid() * 8 + (tid_ >> 6), nw = gridDim.x * 8;
    unsigned char* out8 = (unsigned char*)out;
    for (int row0 = gw; row0 < T; row0 += 2 * nw) {
        const int row1 = row0 + nw; const bool has1 = row1 < T; const int r1 = has1 ? row1 : row0;
        const float* xa = xin + (size_t)row0 * DM; const float* xb = xin + (size_t)r1 * DM; f32x4 va[8], vb[8]; float sa = 0.f, sb = 0.f;
#pragma unroll
        for (int j = 0; j < 4; ++j) {
            const int c8 = j * 512 + lane * 8;
            if (inb16) { const u32x4 wa_ = *(const u32x4*)((const bf16_t*)xin + (size_t)row0 * DM + c8), wb_ = *(const u32x4*)((const bf16_t*)xin + (size_t)r1 * DM + c8);
                va[2 * j] = f32x4{bflo(wa_.x), bfhi(wa_.x), bflo(wa_.y), bfhi(wa_.y)}; va[2 * j + 1] = f32x4{bflo(wa_.z), bfhi(wa_.z), bflo(wa_.w), bfhi(wa_.w)};
                vb[2 * j] = f32x4{bflo(wb_.x), bfhi(wb_.x), bflo(wb_.y), bfhi(wb_.y)}; vb[2 * j + 1] = f32x4{bflo(wb_.z), bfhi(wb_.z), bflo(wb_.w), bfhi(wb_.w)}; }
            else { va[2 * j] = *(const f32x4*)(xa + c8); va[2 * j + 1] = *(const f32x4*)(xa + c8 + 4); vb[2 * j] = *(const f32x4*)(xb + c8); vb[2 * j + 1] = *(const f32x4*)(xb + c8 + 4); } }
#pragma unroll
        for (int k = 0; k < 8; ++k) { sa += va[k][0] * va[k][0] + va[k][1] * va[k][1] + va[k][2] * va[k][2] + va[k][3] * va[k][3]; sb += vb[k][0] * vb[k][0] + vb[k][1] * vb[k][1] + vb[k][2] * vb[k][2] + vb[k][3] * vb[k][3]; }
        sa = wave_sum(sa); sb = wave_sum(sb); const float ra = rsqrtf(sa * (1.f / DM) + EPS), rb = rsqrtf(sb * (1.f / DM) + EPS);
        const float* ma = modl + (size_t)(row0 >> 13) * 6 * DM; const float* mb = modl + (size_t)(r1 >> 13) * 6 * DM;
#pragma unroll
        for (int j = 0; j < 4; ++j) { const int c8 = j * 512 + lane * 8;
#pragma unroll
            for (int rw = 0; rw < 2; ++rw) { if (rw == 1 && !has1) break;
                const float* mm = rw ? mb : ma; const float rr = rw ? rb : ra; const size_t ro = (size_t)(rw ? row1 : row0) * DM + c8;
                f32x4 y[2];
#pragma unroll
                for (int hh = 0; hh < 2; ++hh) { const int c = c8 + 4 * hh; const f32x4 g = *(const f32x4*)(gain + c), sc = *(const f32x4*)(mm + scale_off + c), sh = *(const f32x4*)(mm + shift_off + c);
                    y[hh] = (rw ? vb[2 * j + hh] : va[2 * j + hh]) * rr * g * (1.f + sc) + sh; }
                int p0 = __builtin_amdgcn_cvt_pk_fp8_f32(y[0][0], y[0][1], 0, false); p0 = __builtin_amdgcn_cvt_pk_fp8_f32(y[0][2], y[0][3], p0, true);
                int p1 = __builtin_amdgcn_cvt_pk_fp8_f32(y[1][0], y[1][1], 0, false); p1 = __builtin_amdgcn_cvt_pk_fp8_f32(y[1][2], y[1][3], p1, true);
                if (f8) *(u32x2*)(out8 + ro) = u32x2{(unsigned)p0, (unsigned)p1};
                else { *(u32x4*)(out + ro) = u32x4{cvt_pk_bf16(y[0][0], y[0][1]), cvt_pk_bf16(y[0][2], y[0][3]), cvt_pk_bf16(y[1][0], y[1][1]), cvt_pk_bf16(y[1][2], y[1][3])};
                       if (out8b) *(u32x2*)(out8b + ro) = u32x2{(unsigned)p0, (unsigned)p1}; } } }
    }
}

__device__ __forceinline__ void mla_cnorm_phase(const bf16_t* Z, const float* g_q, const float* g_kv, unsigned char* CQN, unsigned char* CKVN) {
    const int tid_ = otid(), lane = tid_ & 63, gw = obid() * 8 + (tid_ >> 6), nw = gridDim.x * 8;
    float gq[8], gk[8];
#pragma unroll
    for (int e = 0; e < 8; ++e) { gq[e] = g_q[lane * 8 + e]; gk[e] = g_kv[lane * 8 + e]; }
    for (int row = gw; row < T; row += nw) {
        const u32x4 a = *(const u32x4*)(Z + (size_t)row * MLA_IN_PAD + lane * 8), b = *(const u32x4*)(Z + (size_t)row * MLA_IN_PAD + 512 + lane * 8);
        float fa[8], fb[8]; unpack8(a, fa); unpack8(b, fb); float sa = 0.f, sb = 0.f;
#pragma unroll
        for (int e = 0; e < 8; ++e) { sa += fa[e] * fa[e]; sb += fb[e] * fb[e]; }
        sa = wave_sum(sa); sb = wave_sum(sb); const float ra = rsqrtf(sa * (1.f / 512) + EPS), rb = rsqrtf(sb * (1.f / 512) + EPS);
#pragma unroll
        for (int e = 0; e < 8; ++e) { fa[e] *= ra * gq[e]; fb[e] *= rb * gk[e]; }
        int a0 = __builtin_amdgcn_cvt_pk_fp8_f32(fa[0], fa[1], 0, false); a0 = __builtin_amdgcn_cvt_pk_fp8_f32(fa[2], fa[3], a0, true);
        int a1 = __builtin_amdgcn_cvt_pk_fp8_f32(fa[4], fa[5], 0, false); a1 = __builtin_amdgcn_cvt_pk_fp8_f32(fa[6], fa[7], a1, true);
        int b0 = __builtin_amdgcn_cvt_pk_fp8_f32(fb[0], fb[1], 0, false); b0 = __builtin_amdgcn_cvt_pk_fp8_f32(fb[2], fb[3], b0, true);
        int b1 = __builtin_amdgcn_cvt_pk_fp8_f32(fb[4], fb[5], 0, false); b1 = __builtin_amdgcn_cvt_pk_fp8_f32(fb[6], fb[7], b1, true);
        u32x2 wa = {(unsigned)a0, (unsigned)a1}, wb = {(unsigned)b0, (unsigned)b1};
        *(u32x2*)(CQN + (size_t)row * 512 + lane * 8) = wa; *(u32x2*)(CKVN + (size_t)row * 512 + lane * 8) = wb;
    }
}

__device__ __forceinline__ void mla_qkv_phase(const bf16_t* __restrict__ QRAW, const bf16_t* __restrict__ KVRAW, const bf16_t* __restrict__ Z, const int* __restrict__ pos, const float* __restrict__ g_qn, const float* __restrict__ g_kn,
                                              bf16_t* __restrict__ Q, bf16_t* __restrict__ K) {
    const int tid_ = otid(), lane = tid_ & 63, gw = obid() * 8 + (tid_ >> 6), nw = gridDim.x * 8;
    const int sub = lane & 31, hsel = lane >> 5;
    const bool isn = sub < 16, isr = sub >= 16 && sub < 24, act = sub < 24;
    const int e0 = isn ? sub * 8 : (128 + (sub - 16) * 8);
    float gq[8], gk[8];
#pragma unroll
    for (int e = 0; e < 8; ++e) { gq[e] = act ? g_qn[e0 + e] : 0.f; gk[e] = act ? g_kn[e0 + e] : 0.f; }
    const float QSC = 0.07216878364870322f * LOG2E;
    for (int row = gw; row < T; row += nw) {
        const int b = row >> 13, s = row & (SEQ - 1);
        float cs[8], sn[8];
        { const float p = (float)pos[row];
#pragma unroll
          for (int e = 0; e < 8; ++e) { const int fi = ((sub & 3) * 8 + e); const float inv = exp2f(-(float)fi * (13.287712379549449f / 32.f)); sincos_rev(p * inv, sn[e], cs[e]); } }
        u32x4 kr = {0u, 0u, 0u, 0u}; if (isr) kr = *(const u32x4*)(Z + (size_t)row * MLA_IN_PAD + 1024 + (sub - 16) * 8);
#pragma unroll 1
        for (int p4 = 0; p4 < 2; ++p4) {
            u32x4 wq[4], wk[4];
#pragma unroll
            for (int i = 0; i < 4; ++i) { const int h = (p4 * 4 + i) * 2 + hsel;
                wq[i] = (u32x4){0u, 0u, 0u, 0u}; if (act) wq[i] = *(const u32x4*)(QRAW + (size_t)row * 3072 + h * 192 + e0);
                wk[i] = kr; if (isn) wk[i] = *(const u32x4*)(KVRAW + (size_t)row * 4096 + h * 256 + sub * 8); }
#pragma unroll
            for (int i = 0; i < 4; ++i) { const int h = (p4 * 4 + i) * 2 + hsel;
#pragma unroll
                for (int qk = 0; qk < 2; ++qk) {
                    float f[8]; unpack8(qk == 0 ? wq[i] : wk[i], f); float ss = 0.f;
#pragma unroll
                    for (int e = 0; e < 8; ++e) ss += f[e] * f[e];
#pragma unroll
                    for (int o = 16; o >= 1; o >>= 1) ss += __shfl_xor(ss, o);
                    const float r = rsqrtf(ss * (1.f / 192) + EPS) * (qk == 0 ? QSC : 1.f);
#pragma unroll
                    for (int e = 0; e < 8; ++e) f[e] *= r * (qk == 0 ? gq[e] : gk[e]);
                    float y[8];
#pragma unroll
                    for (int e = 0; e < 8; ++e) { const float px = __shfl_xor(f[e], 4); y[e] = isr ? ((sub < 20) ? (f[e] * cs[e] - px * sn[e]) : (f[e] * cs[e] + px * sn[e])) : f[e]; }
                    if (act) { u32x4 o = {cvt_pk_bf16(y[0], y[1]), cvt_pk_bf16(y[2], y[3]), cvt_pk_bf16(y[4], y[5]), cvt_pk_bf16(y[6], y[7])};
                        *(u32x4*)((qk == 0 ? Q : K) + ((size_t)(b * MLA_H + h) * SEQ + s) * 192 + e0) = o; }
                }
            }
        }
    }
}

__device__ __forceinline__ void dil_combine_phase(const bf16_t* OG, const float* LSE, bf16_t* O) {
    const int tid_ = otid(), lane = tid_ & 63, gw = obid() * 8 + (tid_ >> 6), nw = gridDim.x * 8;
    for (int row = gw; row < T; row += nw) {
#pragma unroll
        for (int k = 0; k < 2; ++k) {
            const int col = k * 1024 + lane * 16, h = col >> 7;
            const float l0 = LSE[((size_t)0 * T + row) * 16 + h], l1 = LSE[((size_t)1 * T + row) * 16 + h], l2 = LSE[((size_t)2 * T + row) * 16 + h];
            const float mx = fmaxf(l0, fmaxf(l1, l2)); float w0 = exp2f(l0 - mx), w1 = exp2f(l1 - mx), w2 = exp2f(l2 - mx); const float inv = 1.f / (w0 + w1 + w2); w0 *= inv; w1 *= inv; w2 *= inv;
            unsigned q[4];
#pragma unroll
            for (int hh = 0; hh < 2; ++hh) { float a[8], b[8], c[8];
                unpack8(*(const u32x4*)(OG + ((size_t)0 * T + row) * DM + col + 8 * hh), a); unpack8(*(const u32x4*)(OG + ((size_t)1 * T + row) * DM + col + 8 * hh), b); unpack8(*(const u32x4*)(OG + ((size_t)2 * T + row) * DM + col + 8 * hh), c);
                float y[8];
#pragma unroll
                for (int e = 0; e < 8; ++e) y[e] = w0 * a[e] + w1 * b[e] + w2 * c[e];
                int q0 = __builtin_amdgcn_cvt_pk_fp8_f32(y[0] * ACT_F8SCALE, y[1] * ACT_F8SCALE, 0, false); q0 = __builtin_amdgcn_cvt_pk_fp8_f32(y[2] * ACT_F8SCALE, y[3] * ACT_F8SCALE, q0, true);
                int q1 = __builtin_amdgcn_cvt_pk_fp8_f32(y[4] * ACT_F8SCALE, y[5] * ACT_F8SCALE, 0, false); q1 = __builtin_amdgcn_cvt_pk_fp8_f32(y[6] * ACT_F8SCALE, y[7] * ACT_F8SCALE, q1, true);
                q[2 * hh] = (unsigned)q0; q[2 * hh + 1] = (unsigned)q1; }
            *(u32x4*)((unsigned char*)O + (size_t)row * DM + col) = u32x4{q[0], q[1], q[2], q[3]};
        }
    }
}

namespace rt {
__device__ __forceinline__ int f2key(float s) { const int u = (int)__float_as_uint(s); return u ^ (int)((unsigned)(u >> 31) >> 1); }
__device__ __forceinline__ float key2f(int k) { return __uint_as_float((unsigned)(k ^ (int)((unsigned)(k >> 31) >> 1))); }
template <int N> __device__ __forceinline__ void sort_desc(int (&v)[N]) {
#pragma unroll
    for (int k = 2; k <= N; k <<= 1) {
#pragma unroll
        for (int j = k >> 1; j > 0; j >>= 1) {
#pragma unroll
            for (int i = 0; i < N; ++i) { const int l = i ^ j;
                if (l > i) { const bool desc = ((i & k) == 0); const int a = v[i], b = v[l]; const int mx = a > b ? a : b, mn = a > b ? b : a; v[i] = desc ? mx : mn; v[l] = desc ? mn : mx; } }
        }
    }
}
__device__ __forceinline__ void bitonic_merge_desc16(int (&v)[16]) {
#pragma unroll
    for (int j = 8; j > 0; j >>= 1) {
#pragma unroll
        for (int i = 0; i < 16; ++i) { const int l = i ^ j; if (l > i) { const int a = v[i], b = v[l]; v[i] = a > b ? a : b; v[l] = a > b ? b : a; } }
    }
}
__device__ __forceinline__ void merge_top16(int (&a)[16], const int (&b)[16]) {
#pragma unroll
    for (int i = 0; i < 16; ++i) { const int x = a[i], y = b[15 - i]; a[i] = x > y ? x : y; }
    bitonic_merge_desc16(a);
}
__device__ __forceinline__ void merge_partner(int (&a)[16], int hi) {
    int b[16];
#pragma unroll
    for (int i = 0; i < 16; ++i) { auto rr = __builtin_amdgcn_permlane32_swap((unsigned)a[i], (unsigned)a[i], false, false); b[i] = (int)(hi ? rr[0] : rr[1]); }
    merge_top16(a, b);
}
#define RT_CAND_LIST(X) X(0,0,0) X(1,0,1) X(2,0,2) X(3,0,3) X(4,0,4) X(5,0,5) X(6,0,6) X(7,0,7) X(8,0,8) X(9,0,9) X(10,0,10) X(11,0,11) X(12,0,12) X(13,0,13) X(14,0,14) X(15,0,15) X(16,1,0) X(17,1,1) X(18,1,2) X(19,1,3) X(20,1,4) X(21,1,5) X(22,1,6) X(23,1,7) X(24,2,0) X(25,2,1) X(26,2,2) X(27,2,3) X(28,2,4) X(29,3,0) X(30,3,1) X(31,3,2) X(32,3,3) X(33,4,0) X(34,4,1) X(35,4,2) X(36,5,0) X(37,5,1) X(38,6,0) X(39,6,1) X(40,7,0) X(41,7,1) X(42,8,0) X(43,9,0) X(44,10,0) X(45,11,0) X(46,12,0) X(47,13,0) X(48,14,0) X(49,15,0)

__device__ __forceinline__ void route_item(const bf16_t* PQ, const bf16_t* SUBK  , int t0, int h, int* IDX, float* GATE, LAS int* lds_w) {
    const int lane = otid() & 63, r32 = lane & 31, hi = lane >> 5;
    int top[2][16];
#pragma unroll
    for (int p = 0; p < 2; ++p) {
        bf16x8 bq[8];
        { const bf16_t* qp = PQ + ((size_t)(((t0 >> 5) * 8 + h) * 2 + p) << 12) + (size_t)lane * 8;
          typedef __attribute__((address_space(1))) const bf16x8* gfrag_t;
          gfrag_t qg = (gfrag_t)qp; asm volatile("" : "+v"(qg));
#pragma unroll
          for (int ks = 0; ks < 8; ++ks) bq[ks] = qg[ks * 64]; }
        int cur[16];
#pragma unroll
        for (int kb = 0; kb < 4; ++kb) { f32x16 acc = f32x16{};
            const bf16_t* kp = SUBK + (size_t)(h * 2 + p) * 16384 + (size_t)(kb * 8 * 64 + lane) * 8;
            typedef __attribute__((address_space(1))) const bf16x8* gfrag_t;
            gfrag_t kg_ = (gfrag_t)kp; asm volatile("" : "+v"(kg_));
            bf16x8 af[8];
#pragma unroll
            for (int ks = 0; ks < 8; ++ks) af[ks] = kg_[ks * 64];
#pragma unroll
            for (int ks = 0; ks < 8; ++ks) acc = __builtin_amdgcn_mfma_f32_32x32x16_bf16(af[ks], bq[ks], acc, 0, 0, 0);
            int v[16];
#pragma unroll
            for (int r = 0; r < 16; ++r) { const int key = kb * 32 + (r & 3) + 8 * (r >> 2) + 4 * hi; v[r] = (f2key(acc[r]) & ~0x7F) | key; }
            sort_desc<16>(v);
            if (kb == 0) {
#pragma unroll
                for (int r = 0; r < 16; ++r) cur[r] = v[r]; }
            else merge_top16(cur, v);
            __builtin_amdgcn_sched_barrier(0); }
        merge_partner(cur, hi);
#pragma unroll
        for (int r = 0; r < 16; ++r) top[p][r] = cur[r];
    }
    float sa[16], sb[16];
#pragma unroll
    for (int r = 0; r < 16; ++r) { sa[r] = key2f(top[0][r] & ~0x7F); sb[r] = key2f(top[1][r] & ~0x7F); }
    int best[16];
    { int cv[64];
#pragma unroll
      for (int n = 50; n < 64; ++n) cv[n] = (int)0x80000000;
#define RT_CX(n, i, j) cv[n] = (f2key(sa[i] + sb[j]) & ~0xFF) | ((i) * 16 + (j));
      RT_CAND_LIST(RT_CX)
#undef RT_CX
#pragma unroll
      for (int gI = 0; gI < 4; ++gI) { int v[16];
#pragma unroll
          for (int r = 0; r < 16; ++r) v[r] = cv[gI * 16 + r];
          sort_desc<16>(v);
          if (gI == 0) {
#pragma unroll
              for (int r = 0; r < 16; ++r) best[r] = v[r]; }
          else merge_top16(best, v); } }
#pragma unroll
    for (int r = 0; r < 16; ++r) { lds_w[r * 64 + lane] = top[0][r]; lds_w[(16 + r) * 64 + lane] = top[1][r]; }
    asm volatile("s_waitcnt lgkmcnt(0)" ::: "memory");
    int eidx[16]; float sc[16]; float mx = -1e30f;
#pragma unroll
    for (int k = 0; k < 16; ++k) { const int code = best[k] & 0xFF; const int a = lds_w[(code >> 4) * 64 + lane], b = lds_w[(16 + (code & 15)) * 64 + lane];
        eidx[k] = (a & 0x7F) * 128 + (b & 0x7F); sc[k] = key2f(a & ~0x7F) + key2f(b & ~0x7F); mx = fmaxf(mx, sc[k]); }
    float sum = 0.f;
#pragma unroll
    for (int k = 0; k < 16; ++k) { sc[k] = __expf(sc[k] - mx); sum += sc[k]; }
    const float inv = 1.f / sum;
    asm volatile("s_waitcnt lgkmcnt(0)" ::: "memory");
    const size_t off = (size_t)(t0 + r32) * 128 + h * 16;
    unsigned* dst = hi ? (unsigned*)(GATE + off) : (unsigned*)(IDX + off);
#pragma unroll
    for (int q = 0; q < 4; ++q) { u32x4 w;
        w.x = hi ? __float_as_uint(sc[q * 4 + 0] * inv) : (unsigned)eidx[q * 4 + 0]; w.y = hi ? __float_as_uint(sc[q * 4 + 1] * inv) : (unsigned)eidx[q * 4 + 1];
        w.z = hi ? __float_as_uint(sc[q * 4 + 2] * inv) : (unsigned)eidx[q * 4 + 2]; w.w = hi ? __float_as_uint(sc[q * 4 + 3] * inv) : (unsigned)eidx[q * 4 + 3];
        *(u32x4*)(dst + q * 4) = w; }
}
}
__device__ __forceinline__ void route_phase(const bf16_t* PQ, const bf16_t* SUBK, int* IDX, float* GATE, LAS unsigned char* lds) {
    const int wid = otid() >> 6, gw = obid() * 8 + wid, nw = gridDim.x * 8;
    LAS int* lw = (LAS int*)(lds + wid * 8192);
    for (int it = gw; it < (T / 32) * PEER_H; it += nw) { const int tt = it >> 3, h = it & 7; rt::route_item(PQ, SUBK, tt * 32, h, IDX, GATE, lw); }
}

__device__ __forceinline__ float gelu_erf(float x) { return 0.5f * x * (1.f + erff(x * 0.70710678118654752f)); }
#define PE_POS(j) ((((j) & 7) << 4) | ((j) >> 3))
constexpr int PE_OFFP = 132, PE_ACTP = 132;
constexpr int PE_VB_PITCH = 136, PE_VB_BYTES = 64 * PE_VB_PITCH;
static_assert(64 * 132 * 4 + 2 * 64 * 128 + 256 + 8 * PE_VB_BYTES + 8 * 1024 <= 128 * 1024, "expert phase LDS");
constexpr int PE_OFF_BYTES = 64 * PE_OFFP * 4, PE_ACT_BYTES = 64 * PE_ACTP * 4;
__device__ __forceinline__ float dot_fp8x4(unsigned w, unsigned xa, unsigned xb, float s) {
    const bf16x2_t q0 = __builtin_amdgcn_cvt_scalef32_pk_bf16_fp8(w, 1.0f, false), q1 = __builtin_amdgcn_cvt_scalef32_pk_bf16_fp8(w, 1.0f, true);
    s = __builtin_amdgcn_fdot2_f32_bf16(q0, __builtin_bit_cast(bf16x2_t, xa), s, false); return __builtin_amdgcn_fdot2_f32_bf16(q1, __builtin_bit_cast(bf16x2_t, xb), s, false);
}
__device__ __forceinline__ void peer_phase(const unsigned char* H8, const int* IDX, const float* GATE, const unsigned char* U, const unsigned char* V, const float* usc, const float* vsc,
                                           const float* xin  , const float* gate2, float* out, int out_b16  , LAS unsigned char* lds) {
    const int tid = otid(), lane = tid & 63, wid = tid >> 6, g = lane >> 3, l8 = lane & 7, tw = wid * 8 + g;
    LAS unsigned* offl = (LAS unsigned*)lds; LAS unsigned char* a8hi = lds + PE_OFF_BYTES; LAS unsigned char* a8lo = a8hi + 64 * 128; LAS float* tscl = (LAS float*)(a8lo + 64 * 128);
    LAS unsigned char* vbw = lds + PE_OFF_BYTES + 2 * 64 * 128 + 256 + wid * PE_VB_BYTES; LAS float* actw = (LAS float*)vbw;
    const LAS u32x4* offrow = (const LAS u32x4*)(offl + tw * PE_OFFP);
    const unsigned lpart = (unsigned)l8 * 16u;
    for (int tile = obid(); tile < T / 64; tile += gridDim.x) {
        const int t0 = tile * 64, t = t0 + tw, b = t >> 13;
        __syncthreads();
        { int iv[16];
#pragma unroll
          for (int q = 0; q < 16; ++q) iv[q] = IDX[(size_t)t0 * 128 + tid + 512 * q];
          const int tp_ = otid();
#pragma unroll
          for (int q = 0; q < 16; ++q) { const int i = tp_ + 512 * q; offl[(i >> 7) * PE_OFFP + PE_POS(i & 127)] = ((unsigned)iv[q]) << 7; } }
        __syncthreads();
        {
            const int lane = otid() & 63;
            const int m16 = lane & 15, kg = lane >> 4;
            const unsigned lpu = (unsigned)((lane & 7) * 16);
            const int bidx = 4 * (8 * (m16 >> 1) + (m16 & 1) + 2 * kg);
            f32x4 acc[8][2];
#pragma unroll
            for (int a_ = 0; a_ < 8; ++a_) { acc[a_][0] = f32x4{0.f, 0.f, 0.f, 0.f}; acc[a_][1] = f32x4{0.f, 0.f, 0.f, 0.f}; }
            const unsigned char* hrow = H8 + (size_t)(t0 + wid * 8) * DM + 64 * (kg >> 1) + 16 * (kg & 1) + 32 * (m16 & 1);
            const LAS u32x4* offw = (const LAS u32x4*)(offl + (wid * 8) * PE_OFFP + (lane >> 3) * 16);
            const int mq = m16 >> 1;
            u32x4 buf[16]; u32x4 hA, hB;
            { const LAS u32x4* offc = offw; asm volatile("" : "+v"(offc));
              const u32x4 o0 = offc[0], o1 = offc[1], o2 = offc[2], o3 = offc[3];
              hA = *(const u32x4*)(hrow); hB = *(const u32x4*)(hrow + 128);
              __builtin_amdgcn_sched_barrier(0);
#define PE_UL(g, ov) buf[g] = *(const u32x4*)((const char*)U + (size_t)((ov) + lpu));
              PE_UL(0, o0.x) PE_UL(8, o2.x) PE_UL(1, o0.y) PE_UL(9, o2.y) PE_UL(2, o0.z) PE_UL(10, o2.z) PE_UL(3, o0.w) PE_UL(11, o2.w)
              PE_UL(4, o1.x) PE_UL(12, o3.x) PE_UL(5, o1.y) PE_UL(13, o3.y) PE_UL(6, o1.z) PE_UL(14, o3.z) PE_UL(7, o1.w) PE_UL(15, o3.w)
#undef PE_UL
              __builtin_amdgcn_sched_barrier(0); }
#define PE_PERM(dst, src) { const u32x4 s_ = (src); (dst).x = (unsigned)__builtin_amdgcn_ds_bpermute(bidx, (int)s_.x); (dst).y = (unsigned)__builtin_amdgcn_ds_bpermute(bidx, (int)s_.y); (dst).z = (unsigned)__builtin_amdgcn_ds_bpermute(bidx, (int)s_.z); (dst).w = (unsigned)__builtin_amdgcn_ds_bpermute(bidx, (int)s_.w); }
            u32x4 tq[4]; PE_PERM(tq[0], buf[0]) PE_PERM(tq[1], buf[8])
#pragma unroll 1
            for (int c = 0; c < 8; ++c) {
                const char* ub = (const char*)(U + (size_t)c * PEER_E * 128);
                const int cn = c + 1 < 8 ? c + 1 : c;
                const char* ubn = (const char*)(U + (size_t)cn * PEER_E * 128);
#pragma unroll
                for (int tk = 0; tk < 8; ++tk) {
                    const int tkn = (tk + 1) & 7; const char* nb_ = tk == 7 ? ubn : ub; const int ccn = tk == 7 ? cn : c;
                    const LAS u32x4* offc = offw + tkn * (PE_OFFP / 4); asm volatile("" : "+v"(offc));
                    const u32x4 o0 = offc[0], o1 = offc[1], o2 = offc[2], o3 = offc[3];
                    const unsigned char* hn = hrow + (size_t)tkn * DM + ccn * 256;
                    const u32x4 hnA = *(const u32x4*)(hn), hnB = *(const u32x4*)(hn + 128);
                    __builtin_amdgcn_sched_barrier(0);
#define PE_UM(q, sft, ovA, ovB) { const bool sel = mq == (q); pg8::i32x8 hv; \
                        hv[0] = sel ? (int)hA.x : 0; hv[1] = sel ? (int)hA.y : 0; hv[2] = sel ? (int)hA.z : 0; hv[3] = sel ? (int)hA.w : 0; hv[4] = sel ? (int)hB.x : 0; hv[5] = sel ? (int)hB.y : 0; hv[6] = sel ? (int)hB.z : 0; hv[7] = sel ? (int)hB.w : 0; \
                        { PE_PERM(tq[(2 * (q) + 2) & 3], buf[((q) + 1) & 7]) const u32x4 t_ = tq[(2 * (q)) & 3]; const pg8::i32x8 rv = {(int)t_.x, (int)t_.y, (int)t_.z, (int)t_.w, 0, 0, 0, 0}; \
                          acc[tk][0] = __builtin_amdgcn_mfma_scale_f32_16x16x128_f8f6f4(hv, rv, acc[tk][0], 0, 4, 0, 0x7F7F7F7F, 0, 0x7F7F7F7F); buf[q] = *(const u32x4*)(nb_ + (size_t)((ovA) + lpu)); } \
                        __builtin_amdgcn_sched_barrier(0); \
                        { PE_PERM(tq[(2 * (q) + 3) & 3], buf[8 + (((q) + 1) & 7)]) const u32x4 t_ = tq[(2 * (q) + 1) & 3]; const pg8::i32x8 rv = {(int)t_.x, (int)t_.y, (int)t_.z, (int)t_.w, 0, 0, 0, 0}; \
                          acc[tk][1] = __builtin_amdgcn_mfma_scale_f32_16x16x128_f8f6f4(hv, rv, acc[tk][1], 0, 4, 0, 0x7F7F7F7F, 0, 0x7F7F7F7F); buf[8 + (q)] = *(const u32x4*)(nb_ + (size_t)((ovB) + lpu)); } \
                        __builtin_amdgcn_sched_barrier(0); }
                    PE_UM(0, 0, o0.x, o2.x) PE_UM(1, 0, o0.y, o2.y) PE_UM(2, 0, o0.z, o2.z) PE_UM(3, 0, o0.w, o2.w) PE_UM(4, 0, o1.x, o3.x) PE_UM(5, 0, o1.y, o3.y) PE_UM(6, 0, o1.z, o3.z) PE_UM(7, 0, o1.w, o3.w)
#undef PE_UM
                    hA = hnA; hB = hnB;
                }
            }
#undef PE_PERM
#pragma unroll
            for (int tk = 0; tk < 8; ++tk)
#pragma unroll
                for (int hs = 0; hs < 2; ++hs) { const f32x4 a_ = acc[tk][hs];
                    const float v0 = a_[0] + __shfl_xor(a_[1], 1), v1 = a_[2] + __shfl_xor(a_[3], 1);
                    if ((m16 & 1) == 0) { LAS float* ap = actw + tk * PE_ACTP + (m16 >> 1) * 16 + hs * 8 + 2 * kg; ap[0] = v0; ap[1] = v1; } }
        }
        {
            const int lane = otid() & 63;
            float gt[8][2], su[8][2], sv[8][2];
#pragma unroll
            for (int tk = 0; tk < 8; ++tk)
#pragma unroll
                for (int hf = 0; hf < 2; ++hf) { const int j = lane + 64 * hf; const unsigned ex = offl[(wid * 8 + tk) * PE_OFFP + PE_POS(j)] >> 7;
                    gt[tk][hf] = GATE[(size_t)(t0 + wid * 8 + tk) * 128 + j]; { typedef float f32x2_t __attribute__((ext_vector_type(2))); const f32x2_t s2_ = *(const f32x2_t*)(usc + 2 * (size_t)ex); su[tk][hf] = s2_[0]; sv[tk][hf] = s2_[1]; } }
            const int kr = (lane & 0x30) == 0x10 ? lane + 16 : ((lane & 0x30) == 0x20 ? lane - 16 : lane);
#pragma unroll
            for (int tk = 0; tk < 8; ++tk) { float av[2]; float mx = 0.f;
#pragma unroll
                for (int hf = 0; hf < 2; ++hf) { const int j = lane + 64 * hf; av[hf] = gelu_erf(actw[tk * PE_ACTP + PE_POS(j)] * su[tk][hf]) * gt[tk][hf] * sv[tk][hf]; mx = fmaxf(mx, fabsf(av[hf])); }
#pragma unroll
                for (int o = 32; o >= 1; o >>= 1) mx = fmaxf(mx, __shfl_xor(mx, o));
                const int exm = (int)((__float_as_uint(mx) >> 23) & 0xff);
                int se = 261 - exm; se = se < 1 ? 1 : (se > 254 ? 254 : se);
                const float sc_ = exm == 0 ? 1.f : __uint_as_float((unsigned)se << 23);
                if (lane == 0) tscl[wid * 8 + tk] = 1.f / sc_;
#pragma unroll
                for (int hf = 0; hf < 2; ++hf) { const float x_ = av[hf] * sc_;
                    const int ph = __builtin_amdgcn_cvt_pk_fp8_f32(x_, 0.f, 0, false); const float hif = __builtin_amdgcn_cvt_f32_fp8(ph, 0);
                    const int pl = __builtin_amdgcn_cvt_pk_fp8_f32(x_ - hif, 0.f, 0, false);
                    a8hi[(wid * 8 + tk) * 128 + hf * 64 + kr] = (unsigned char)(ph & 0xff); a8lo[(wid * 8 + tk) * 128 + hf * 64 + kr] = (unsigned char)(pl & 0xff); } }
        }
        {
            const int lane = otid() & 63;
            const int q16 = lane & 15, kg = lane >> 4, kgm = kg & 1, r8 = lane >> 3, p8 = lane & 7;
            const LAS unsigned char* tr1 = vbw + (16 * kgm + q16) * PE_VB_PITCH + 32 * (kg >> 1); const LAS unsigned char* tr2 = tr1 + 32 * PE_VB_PITCH;
            LAS unsigned char* wr = vbw + r8 * PE_VB_PITCH + p8 * 16;
            const LAS u32x4* offw = (const LAS u32x4*)(offl + (wid * 8) * PE_OFFP + r8 * 16);
            const unsigned lpv = (unsigned)(p8 * 16);
            const int vsel = q16 >> 2, vhl = q16 & 3;
            const LAS unsigned char* a8p = ((vhl & 1) == 0 ? a8hi : a8lo) + (wid * 8) * 128 + 16 * kg;
            typedef int i32x2_t __attribute__((ext_vector_type(2)));
            LAS float* ystg = (LAS float*)(lds + PE_OFF_BYTES + 2 * 64 * 128 + 256 + 8 * PE_VB_BYTES + wid * 1024);
            u32x4 buf[16];
            { const LAS u32x4* offc = offw; asm volatile("" : "+v"(offc)); const u32x4 o0 = offc[0], o1 = offc[1], o2 = offc[2], o3 = offc[3];
#define PE_VL(g, ov, base_) buf[g] = *(const u32x4*)((base_) + (size_t)((ov) + lpv));
              PE_VL(0, o0.x, (const char*)V) PE_VL(1, o0.y, (const char*)V) PE_VL(2, o0.z, (const char*)V) PE_VL(3, o0.w, (const char*)V) PE_VL(4, o1.x, (const char*)V) PE_VL(5, o1.y, (const char*)V) PE_VL(6, o1.z, (const char*)V) PE_VL(7, o1.w, (const char*)V)
              PE_VL(8, o2.x, (const char*)V) PE_VL(9, o2.y, (const char*)V) PE_VL(10, o2.z, (const char*)V) PE_VL(11, o2.w, (const char*)V) PE_VL(12, o3.x, (const char*)V) PE_VL(13, o3.y, (const char*)V) PE_VL(14, o3.z, (const char*)V) PE_VL(15, o3.w, (const char*)V)
              __builtin_amdgcn_sched_barrier(0); }
#pragma unroll 1
            for (int c = 0; c < 8; ++c) {
                const char* vb_ = (const char*)(V + (size_t)c * PEER_E * 128);
                const int cn = c + 1 < 8 ? c + 1 : c;
                const char* vbn = (const char*)(V + (size_t)cn * PEER_E * 128);
                const f32x4 gr = *(const f32x4*)(gate2 + (size_t)(t0 >> 13) * 6 * DM + c * 256 + 4 * lane);
#pragma unroll 1
                for (int tk = 0; tk < 8; ++tk) {
                    const int tkn = (tk + 1) & 7; const char* nb_ = tk == 7 ? vbn : vb_;
                    const LAS u32x4* offc = offw + tkn * (PE_OFFP / 4); asm volatile("" : "+v"(offc));
                    const int tt = t0 + wid * 8 + tk; const int colb = c * 256 + 16 * kg + q16;
                    const u32x2 xw = *(const u32x2*)((const bf16_t*)xin + (size_t)tt * DM + c * 256 + 4 * lane);
                    const float tsc = tscl[wid * 8 + tk];
                    f32x4 acc[2];
#pragma unroll
                    for (int bq = 0; bq < 2; ++bq) acc[bq] = f32x4{0.f, 0.f, 0.f, 0.f};
#pragma unroll
                    for (int hu = 0; hu < 2; ++hu) {
                        const u32x4 on0 = offc[2 * hu], on1 = offc[2 * hu + 1];
#pragma unroll
                        for (int g8 = 0; g8 < 8; ++g8) { const u32x4 d_ = buf[hu * 8 + g8]; *(LAS u32x2*)(wr + g8 * 8 * PE_VB_PITCH) = u32x2{d_.x, d_.y}; *(LAS u32x2*)(wr + g8 * 8 * PE_VB_PITCH + 8) = u32x2{d_.z, d_.w}; }
                        { const unsigned ov[8] = {on0.x, on0.y, on0.z, on0.w, on1.x, on1.y, on1.z, on1.w};
#pragma unroll
                          for (int g8 = 0; g8 < 8; ++g8) buf[hu * 8 + g8] = *(const u32x4*)(nb_ + (size_t)(ov[g8] + lpv)); }
                        const u32x4 araw = *(const LAS u32x4*)(a8p + tk * 128 + hu * 64);
                        __builtin_amdgcn_sched_barrier(0);
                        i32x2_t ta[4], tb[4];
#define PE_TR(st) { const int nb_k = 8 * ((st) & 1) + ((st) >> 1); ta[(st) & 3] = __builtin_amdgcn_ds_read_tr4_b64_v2i32((LAS i32x2_t*)(tr1 + 8 * nb_k)); tb[(st) & 3] = __builtin_amdgcn_ds_read_tr4_b64_v2i32((LAS i32x2_t*)(tr2 + 8 * nb_k)); }
                        PE_TR(0) PE_TR(1) PE_TR(2)
#pragma unroll
                        for (int st = 0; st < 8; ++st) { const int vr = st >> 1, bq = st & 1; const bool s0 = (vsel == vr) && (vhl < 2), s1 = (vsel == vr) && (vhl >= 2);
                            const pg8::i32x8 hv = {s0 ? (int)araw.x : 0, s0 ? (int)araw.y : 0, s0 ? (int)araw.z : 0, s0 ? (int)araw.w : 0, s1 ? (int)araw.x : 0, s1 ? (int)araw.y : 0, s1 ? (int)araw.z : 0, s1 ? (int)araw.w : 0};
                            if (st + 3 < 8) PE_TR(st + 3)
                            const pg8::i32x8 rv = {ta[st & 3].x, ta[st & 3].y, tb[st & 3].x, tb[st & 3].y, 0, 0, 0, 0};
                            acc[bq] = __builtin_amdgcn_mfma_scale_f32_16x16x128_f8f6f4(hv, rv, acc[bq], 0, 4, 0, 0x7F7F7F7F, 0, 0x7F7F7F7F);
                            __builtin_amdgcn_sched_barrier(0); }
#undef PE_TR
                        __builtin_amdgcn_sched_barrier(0);
                    }
#pragma unroll
                    for (int bq = 0; bq < 2; ++bq)
#pragma unroll
                        for (int sb = 0; sb < 2; ++sb) ystg[128 * bq + 64 * sb + 16 * kg + q16] = (acc[bq][2 * sb] + acc[bq][2 * sb + 1]) * tsc;
                    { const f32x4 yv = *(const LAS f32x4*)(ystg + 4 * lane); const f32x4 xr = {bflo(xw.x), bfhi(xw.x), bflo(xw.y), bfhi(xw.y)}; const f32x4 o_ = xr + gr * yv; const size_t oi = (size_t)tt * DM + c * 256 + 4 * lane;
                      if (out_b16) *(u32x2*)((bf16_t*)out + oi) = u32x2{cvt_pk_bf16(o_[0], o_[1]), cvt_pk_bf16(o_[2], o_[3])}; else *(f32x4*)(out + oi) = o_; }
                }
            }
#undef PE_VL
        }
#undef PE_ISSUE
    }
}

constexpr int NPL = 13, NPH = 1 + DEPTH * NPL;
__host__ __device__ constexpr bool phase_exists(int ph) { if (ph == 0) return true; const int k = (ph - 1) % NPL, layer = (ph - 1) / NPL; return ((layer & 1) == 0) ? !(k == 6 || k == 7) : !(k == 2 || k == 5); }
__global__ void __launch_bounds__(512, 2) fwd_kernel(Args A) {
    extern __shared__ __attribute__((aligned(16))) unsigned char lds_raw[];
    LAS unsigned char* lds = (LAS unsigned char*)lds_raw;
    unsigned char* ws_ = A.ws;
#define WSB ow(ws_)
    const int G = gridDim.x, bid = blockIdx.x;
    volatile LAS unsigned* misc = (volatile LAS unsigned*)(lds + LDS_MAIN);
    if (threadIdx.x < 4) misc[threadIdx.x] = 0u;
    __syncthreads();
    XcdBarrier bar; bar.bar = (unsigned*)(WSB + WS_CTL); bar.x = 0; bar.st = misc;
    const bool fused = (A.ph_hi - A.ph_lo) > 1;
    if (fused) bar = xcd_barrier_post((unsigned*)(WSB + WS_CTL), misc);
    const float* MOD = (const float*)(WSB + WS_CTL + CTL_MOD_OFF);
#define HB ((bf16_t*)(WSB + WS_HB))
#define XA ((float*)(WSB + WS_XA))
#define XB ((float*)(WSB + WS_XB))
    bf16_t* OB = (bf16_t*)A.out;
#define PQ ((bf16_t*)(WSB + WS_PQ))
#define IDX ((int*)(WSB + WS_IDX))
#define GATE ((float*)(WSB + WS_GATE))
#define R1 (WSB + WS_R1)
#define IN(k) (A.ph_lo <= (k) && (k) < A.ph_hi)
#define SEAM(k) do { if ((k) + 1 < A.ph_hi) xcd_barrier(bar); } while (0)
#define REPS(bit) for (int rp_ = 0; rp_ < ((((REP_MASK) >> (bit)) & 1) ? 2 : 1); ++rp_)
#define REPB(bit) do { if ((((REP_MASK) >> (bit)) & 1) && fused) xcd_barrier(bar); } while (0)
    if (IN(0)) { REPS(0) { prologue_phase(A, lds); REPB(0); } SEAM(0); }
#pragma unroll 1
    for (int layer = 0; layer < DEPTH; ++layer) {
        const int pb = 1 + layer * NPL;
        const float* modl = MOD + (size_t)layer * 2 * 6 * DM;
        const float* xcur = layer == 0 ? A.x : XB;
        float* xout = layer == DEPTH - 1 ? A.out : XB;
        const bool mla = (layer & 1) == 0;
        if (IN(pb + 0)) { REPS(1) { norm_phase(xcur, A.norm_g + (size_t)(layer * 2 + 0) * DM, modl, 0, DM, HB, 1, nullptr, layer > 0); REPB(1); } SEAM(pb + 0); }
        const int nsub = mla ? 1 : 2;
#pragma unroll 1
        for (int sb = 0; sb < nsub; ++sb) {
            if (IN(pb + 1 + 3 * sb)) {
                pg8::Gemm g; pg8::EpiBf16 E;
                if (mla) { g = pg8::Gemm{HB, (const bf16_t*)(WSB + WS_WIN_MLA), T, MLA_IN_PAD, DM / 2}; E = pg8::EpiBf16{(bf16_t*)(R1 + R1_Z), MLA_IN_PAD, 0, nullptr, nullptr, nullptr, nullptr, nullptr, 1.f / DIL_WSCALE, nullptr}; }
                else { const unsigned* csT = (const unsigned*)(WSB + WS_ROPE) + (size_t)sb * SEQ * 64;
                       g = pg8::Gemm{(const bf16_t*)((const unsigned char*)HB + (size_t)sb * SEQ * DM), (const bf16_t*)(WSB + WS_WIN_DIL), SEQ, DIL_IN, DM / 2};
                       E = pg8::EpiBf16{(bf16_t*)(R1 + R1_ZD), DIL_IN, 1, csT, nullptr, A.dil_g_qn, A.dil_g_kn, (LAS float*)(lds + LDS_XCH), 1.f / DIL_WSCALE, nullptr}; }
                pg8::StaticOrder S; S.init(g.M, g.N, G, bid);
                REPS(2) { pg8::gemm_phase<pg8::EpiBf16, pg8::StaticOrder, true>(lds, g, S, E); REPB(2); }
                SEAM(pb + 1 + 3 * sb);
            }
            if (mla && IN(pb + 2)) {
                REPS(3) { mla_cnorm_phase((const bf16_t*)(R1 + R1_Z), A.mla_g_q, A.mla_g_kv, R1 + R1_CQN, R1 + R1_CKVN); REPB(3); }
                SEAM(pb + 2);
            }
            if (mla) {
                if (IN(pb + 3)) {
                    REPS(4) {
#pragma unroll 1
                    for (int w = 0; w < 2; ++w) {
                        pg8::Gemm g = w == 0 ? pg8::Gemm{(const bf16_t*)(R1 + R1_CQN), (const bf16_t*)(WSB + WS_WUQ), T, 3072, 256} : pg8::Gemm{(const bf16_t*)(R1 + R1_CKVN), (const bf16_t*)(WSB + WS_WUKV), T, 4096, 256};
                        pg8::EpiBf16 E = w == 0 ? pg8::EpiBf16{(bf16_t*)(WSB + WS_QRAW), 3072, 0, nullptr, nullptr, nullptr, nullptr, nullptr, 1.f / DIL_WSCALE, nullptr} : pg8::EpiBf16{(bf16_t*)(WSB + WS_KVRAW), 4096, 0, nullptr, nullptr, nullptr, nullptr, nullptr, 1.f / DIL_WSCALE, (bf16_t*)(R1 + R1_V)};
                        pg8::StaticOrder S; S.init(g.M, g.N, G, bid);
                        pg8::gemm_phase<pg8::EpiBf16, pg8::StaticOrder, true>(lds, g, S, E);
                    }
                    REPB(4); }
                    SEAM(pb + 3);
                }
                if (IN(pb + 4)) {
                    REPS(5) { mla_qkv_phase((const bf16_t*)(WSB + WS_QRAW), (const bf16_t*)(WSB + WS_KVRAW), (const bf16_t*)(R1 + R1_Z), A.pos, A.mla_g_qn, A.mla_g_kn, (bf16_t*)(R1 + R1_Q), (bf16_t*)(R1 + R1_K)); REPB(5); }
                    SEAM(pb + 4);
                }
                if (IN(pb + 5)) {
                    const bf16_t* Qb = (const bf16_t*)(R1 + R1_Q); const bf16_t* Kb = (const bf16_t*)(R1 + R1_K); const bf16_t* Vb = (const bf16_t*)(R1 + R1_V);
                    REPS(6) {
                    for (int x = bid; x < 512; x += G) {
                        const int xl = x & 255, xcd = xl & 7, idx = xl >> 3; const int bh = (x >> 8) * 16 + xcd * 2 + (idx >> 4), y = idx & 15, b = bh >> 4, h = bh & 15;
#pragma unroll 1
                        for (int pass = 0; pass < 2; ++pass) {
                            const int qb = pass == 0 ? 31 - y : y;
                            at::Item it; it.Q = Qb + (size_t)bh * SEQ * 192; it.K = Kb + (size_t)bh * SEQ * 192; it.V = Vb + (size_t)bh * SEQ * 128;
                            it.O = (bf16_t*)((unsigned char*)OB + (size_t)b * SEQ * DM + h * 128); it.o_f8 = 1; it.LSE = nullptr; it.qs = 192; it.ks = 192; it.vs = 128; it.os = DM; it.ls = 0; it.i0 = qb * 256; it.W = 1 << 30; it.L = SEQ;
                            at::attn_block<192>(it, (LAS char*)lds);
                        }
                    }
                    REPB(6); }
                    SEAM(pb + 5);
                }
            } else {
                if (IN(pb + 3 + 3 * sb)) {
                    bf16_t* ZD = (bf16_t*)(R1 + R1_ZD); bf16_t* OG = (bf16_t*)(WSB + WS_OG); float* LSE = (float*)(WSB + WS_LSE);
                    REPS(7) {
                    for (int id = bid; id < 1536; id += G) {
                        const int g = id >> 9, rem = id & 511; const int dsh = 2 * g, dil = 1 << dsh, L = SEQ >> dsh, nqb = L >> 8;
                        const int qb = rem % nqb, r2 = rem / nqb, h = r2 & 15, r = r2 >> 4;
                        at::Item it; const size_t tok0 = (size_t)sb * SEQ + r;
                        const bf16_t* zb = ZD + ((size_t)(g * 3 * 16 + h) * SEQ + (size_t)r * L) * 128;
                        it.Q = zb; it.K = zb + (size_t)16 * SEQ * 128; it.V = zb + (size_t)32 * SEQ * 128; it.qs = it.ks = it.vs = 128;
                        it.O = OG + ((size_t)g * T + tok0) * DM + h * 128; it.os = (long)dil * DM; it.LSE = LSE + ((size_t)g * T + tok0) * 16 + h; it.ls = (long)dil * 16;
                        it.i0 = qb * 256; it.W = 129; it.L = L; it.o_f8 = 0;
                        at::attn_block<128>(it, (LAS char*)lds);
                    }
                    REPB(7); }
                    SEAM(pb + 3 + 3 * sb);
                }
            }
        }
        if (!mla && IN(pb + 7)) { REPS(8) { dil_combine_phase((const bf16_t*)(WSB + WS_OG), (const float*)(WSB + WS_LSE), OB); REPB(8); } SEAM(pb + 7); }
        if (IN(pb + 8)) {
            pg8::Gemm g{OB, (const bf16_t*)(WSB + (mla ? WS_WO_MLA : WS_WO_DIL)), T, DM, DM / 2};
            pg8::EpiResGate E{xcur, modl + 2 * DM, 6 * DM, (bf16_t*)XA, DM, 1.f / (ACT_F8SCALE * DIL_WSCALE), layer > 0};
            pg8::StaticOrder S; S.init(g.M, g.N, G, bid);
            REPS(9) { pg8::gemm_phase<pg8::EpiResGate, pg8::StaticOrder, true>(lds, g, S, E); REPB(9); }
            SEAM(pb + 8);
        }
        if (IN(pb + 9)) {
            REPS(10) { norm_phase(XA, A.norm_g + (size_t)(layer * 2 + 1) * DM, modl, 3 * DM, 4 * DM, HB, 0, R1  , 1);
            tables_phase(A.peer_u + (size_t)layer * PEER_E * DM, A.peer_v + (size_t)layer * PEER_E * DM, WSB + WS_UTAB, WSB + WS_VTAB, (float*)(WSB + WS_USC), (float*)(WSB + WS_USC) + 1); REPB(10); }
            SEAM(pb + 9);
        }
        if (IN(pb + 10)) {
            pg8::Gemm g{HB, (const bf16_t*)(WSB + WS_WQ) + (size_t)layer * DM * DM, T, DM, DM};
            pg8::EpiBf16 E{PQ, DM, 2, nullptr, nullptr, nullptr, nullptr, nullptr, 1.f, nullptr};
            pg8::StaticOrder S; S.init(g.M, g.N, G, bid);
            REPS(11) { pg8::gemm_phase<pg8::EpiBf16, pg8::StaticOrder>(lds, g, S, E); REPB(11); }
            SEAM(pb + 10);
        }
        if (IN(pb + 11)) { REPS(12) { route_phase(PQ, (const bf16_t*)(WSB + WS_SUBK) + (size_t)layer * 8 * 2 * 128 * 128, IDX, GATE, lds); REPB(12); } SEAM(pb + 11); }
        if (IN(pb + 12)) {
            REPS(13) { peer_phase(R1, IDX, GATE, WSB + WS_UTAB, WSB + WS_VTAB, (const float*)(WSB + WS_USC), (const float*)(WSB + WS_VSC), XA, modl + 5 * DM, xout, layer + 1 < DEPTH, lds); REPB(13); }
            SEAM(pb + 12);
        }
    }
#undef IN
#undef SEAM
#undef REPS
#undef REPB
}

#undef WSB
#undef HB
#undef XA
#undef XB
#undef PQ
#undef IDX
#undef GATE
#undef R1
extern "C" void kernel_launch(void* const* d_in, const int* in_sizes, int n_in, void* d_out, int out_size, void* d_ws, size_t ws_size, hipStream_t stream) {
    static int grid = 0;
    if (grid == 0) {
        if (n_in != 22 || out_size != T * DM || ws_size < WS_END) { fprintf(stderr, "kernel_launch: unexpected shapes (n_in %d out %d ws %zu need %zu)\n", n_in, out_size, ws_size, (size_t)WS_END); grid = -1; return; }
        int dev = 0, cus = 0, per_cu = 0;
        if (hipGetDevice(&dev) != hipSuccess || hipDeviceGetAttribute(&cus, hipDeviceAttributeMultiprocessorCount, dev) != hipSuccess) { grid = -1; return; }
        if (hipFuncSetAttribute((const void*)fwd_kernel, hipFuncAttributeMaxDynamicSharedMemorySize, LDS_BYTES) != hipSuccess) { fprintf(stderr, "kernel_launch: hipFuncSetAttribute failed\n"); grid = -1; return; }
        if (hipOccupancyMaxActiveBlocksPerMultiprocessor(&per_cu, (const void*)fwd_kernel, 512, LDS_BYTES) != hipSuccess || per_cu < 1) { fprintf(stderr, "kernel_launch: occupancy query says %d\n", per_cu); (void)hipGetLastError(); }
        grid = cus;
    }
    if (grid < 0) return;
    (void)hipMemsetAsync((char*)d_ws + WS_CTL, 0, 16 * 1024, stream);
    Args a{};
    a.x = (const float*)d_in[0]; a.c = (const float*)d_in[1]; a.pos = (const int*)d_in[2]; a.ada_w = (const float*)d_in[3]; a.ada_b = (const float*)d_in[4]; a.norm_g = (const float*)d_in[5];
    a.mla_w_in = (const float*)d_in[6]; a.mla_g_q = (const float*)d_in[7]; a.mla_w_uq = (const float*)d_in[8]; a.mla_g_kv = (const float*)d_in[9]; a.mla_w_ukv = (const float*)d_in[10];
    a.mla_g_qn = (const float*)d_in[11]; a.mla_g_kn = (const float*)d_in[12]; a.mla_w_o = (const float*)d_in[13];
    a.dil_w_in = (const float*)d_in[14]; a.dil_g_qn = (const float*)d_in[15]; a.dil_g_kn = (const float*)d_in[16]; a.dil_w_o = (const float*)d_in[17];
    a.peer_w_q = (const float*)d_in[18]; a.peer_sub_keys = (const float*)d_in[19]; a.peer_u = (const float*)d_in[20]; a.peer_v = (const float*)d_in[21];
    a.out = (float*)d_out; a.ws = (unsigned char*)d_ws;
#if MK_ONE_LAUNCH
    a.ph_lo = 0; a.ph_hi = NPH;
    hipLaunchKernelGGL(fwd_kernel, dim3(grid), dim3(512), LDS_BYTES, stream, a);
#else
    for (int ph = 0; ph < NPH; ++ph) {
        if (!phase_exists(ph)) continue;
        a.ph_lo = ph; a.ph_hi = ph + 1;
        hipLaunchKernelGGL(fwd_kernel, dim3(grid), dim3(512), LDS_BYTES, stream, a);
    }
#endif
}

#ifdef PHASE_AUDIT
#define AUD_LDS extern __shared__ __attribute__((aligned(16))) unsigned char lds_raw[]; LAS unsigned char* lds = (LAS unsigned char*)lds_raw
__global__ void __launch_bounds__(512, 2) aud_prologue(Args A) { AUD_LDS; prologue_phase(A, lds); }
__global__ void __launch_bounds__(512, 2) aud_norm(Args A) { norm_phase(A.x, A.norm_g, A.ada_b, 0, DM, (bf16_t*)A.ws, A.ph_lo); }
__global__ void __launch_bounds__(512, 2) aud_gemm_bf16(Args A) { AUD_LDS; pg8::Gemm g{(const bf16_t*)A.ws, (const bf16_t*)A.ws + 1000000, T, A.ph_lo, A.ph_hi}; pg8::EpiBf16 E{(bf16_t*)A.out, A.ph_lo, A.ph_hi & 1, (const unsigned*)A.x, A.c, A.ada_b, A.norm_g, (LAS float*)(lds + LDS_XCH), 1.f, nullptr}; pg8::StaticOrder S; S.init(g.M, g.N, gridDim.x, blockIdx.x); pg8::gemm_phase<pg8::EpiBf16, pg8::StaticOrder>(lds, g, S, E); }
__global__ void __launch_bounds__(512, 2) aud_gemm_f8(Args A) { AUD_LDS; pg8::Gemm g{(const bf16_t*)A.ws, (const bf16_t*)A.ws + 1000000, T, A.ph_lo, A.ph_hi}; pg8::EpiBf16 E{(bf16_t*)A.out, A.ph_lo, A.ph_hi & 1, (const unsigned*)A.x, A.c, A.ada_b, A.norm_g, (LAS float*)(lds + LDS_XCH), 0.5f, nullptr}; pg8::StaticOrder S; S.init(g.M, g.N, gridDim.x, blockIdx.x); pg8::gemm_phase<pg8::EpiBf16, pg8::StaticOrder, true>(lds, g, S, E); }
__global__ void __launch_bounds__(512, 2) aud_gemm_res(Args A) { AUD_LDS; pg8::Gemm g{(const bf16_t*)A.ws, (const bf16_t*)A.ws + 1000000, T, A.ph_lo, A.ph_hi}; pg8::EpiResGate E{A.x, A.c, 6 * DM, (bf16_t*)A.out, DM, 0.5f, A.ph_lo}; pg8::StaticOrder S; S.init(g.M, g.N, gridDim.x, blockIdx.x); pg8::gemm_phase<pg8::EpiResGate, pg8::StaticOrder>(lds, g, S, E); }
__global__ void __launch_bounds__(512, 2) aud_cnorm(Args A) { mla_cnorm_phase((const bf16_t*)A.ws, A.mla_g_q, A.mla_g_kv, (unsigned char*)A.out, (unsigned char*)A.out + 100000); }
__global__ void __launch_bounds__(512, 2) aud_qkv(Args A) { mla_qkv_phase((const bf16_t*)A.ws, (const bf16_t*)A.ws + 1000, (const bf16_t*)A.ws + 2000, A.pos, A.mla_g_qn, A.mla_g_kn, (bf16_t*)A.out, (bf16_t*)A.out + 1000); }
__global__ void __launch_bounds__(512, 2) aud_comb(Args A) { dil_combine_phase((const bf16_t*)A.ws, A.x, (bf16_t*)A.out); }
__global__ void __launch_bounds__(512, 2) aud_attn192(Args A) { AUD_LDS; at::Item it; it.Q = (const bf16_t*)A.ws; it.K = it.Q + 1000; it.V = it.Q + 2000; it.O = (bf16_t*)A.out; it.LSE = nullptr; it.qs = 192; it.ks = 192; it.vs = 128; it.os = DM; it.ls = 0; it.i0 = A.ph_lo * 256; it.W = 1 << 30; it.L = SEQ; it.o_f8 = A.ph_hi & 1; at::attn_block<192>(it, (LAS char*)lds); }
__global__ void __launch_bounds__(512, 2) aud_attn128(Args A) { AUD_LDS; at::Item it; it.Q = (const bf16_t*)A.ws; it.K = it.Q + 1000; it.V = it.Q + 2000; it.O = (bf16_t*)A.out; it.LSE = (float*)A.out + 5000; it.qs = A.ph_hi; it.ks = A.ph_hi; it.vs = A.ph_hi; it.os = DM; it.ls = 16; it.i0 = A.ph_lo * 256; it.W = 129; it.L = SEQ; it.o_f8 = 0; at::attn_block<128>(it, (LAS char*)lds); }
__global__ void __launch_bounds__(512, 2) aud_route(Args A) { AUD_LDS; route_phase((const bf16_t*)A.ws, (const bf16_t*)A.ws + 100000, (int*)A.out, A.out + 100000, lds); }
__global__ void __launch_bounds__(512, 2) aud_peer(Args A) { AUD_LDS; peer_phase((const unsigned char*)A.ws, A.pos, A.x, A.ws + 1000, A.ws + 2000, A.c, A.c, A.c, A.ada_b, A.out, A.ph_lo, lds); }
#endif
```
